# Optimizing an MI355X kernel written in HIP

```python
import math
import jax, jax.numpy as jnp
from jax import lax
import numpy as np

D_MODEL = 1024
BATCH = 8
SEQ = 8192
DEPTH = 4

N_MIXERS = 4
MIX_WIDTH = D_MODEL
GROUP_WIDTH = MIX_WIDTH // N_MIXERS
SC_HEAD_DIM = 64
SC_TAPS = 3
POOL_WINDOWS = (2, 4, 8, 16)
POOL_GROUP = GROUP_WIDTH // len(POOL_WINDOWS)
CF_TAPS = 31
SSM_CH = 16
SSM_GROUPS = GROUP_WIDTH // SSM_CH
SSM_STATE = 64
SSM_DT_MIN = 1e-3
SSM_DT_MAX = 1e-1
D_FF = -(-(8 * D_MODEL) // (3 * 256)) * 256
IN_SIZES = (GROUP_WIDTH, GROUP_WIDTH, GROUP_WIDTH, GROUP_WIDTH, GROUP_WIDTH, GROUP_WIDTH, GROUP_WIDTH)
IN_WIDTH = sum(IN_SIZES)
IN_SPLITS = tuple(int(v) for v in np.cumsum(IN_SIZES)[:-1])
ALPHA = (2 * DEPTH) ** 0.25
BETA = (8 * DEPTH) ** -0.25
LN_EPS = 1e-5

kernel_name = "hybrid_parallel_mixer_trunk"


def layer_norm(x, g, b):
    xf = x.astype(jnp.float32)
    mu = jnp.mean(xf, axis=-1, keepdims=True)
    var = jnp.mean(jnp.square(xf - mu), axis=-1, keepdims=True)
    y = (xf - mu) * lax.rsqrt(var + LN_EPS) * g.astype(jnp.float32) + b.astype(jnp.float32)
    return y.astype(x.dtype)


def causal_dwconv(x, w):
    k, ch = w.shape
    return lax.conv_general_dilated(
        x, w[:, None, :].astype(x.dtype), window_strides=(1,), padding=[(k - 1, 0)],
        dimension_numbers=('NWC', 'WIO', 'NWC'), feature_group_count=ch)


def pool_mixer(z, w_pool, scale):
    zf = z.astype(jnp.float32)
    s = z.shape[1]
    pos = jnp.arange(1, s + 1, dtype=jnp.float32)[None, :, None]
    outs = []
    for i, w in enumerate(POOL_WINDOWS):
        zg = zf[..., i * POOL_GROUP:(i + 1) * POOL_GROUP]
        cs = jnp.cumsum(zg, axis=1)
        lagged = jnp.pad(cs, ((0, 0), (w, 0), (0, 0)))[:, :s]
        mean = (cs - lagged) / jnp.minimum(pos, float(w))
        outs.append(jnp.einsum('bsc,cd->bsd', mean - zg, w_pool[i].astype(jnp.float32)))
    return (jnp.concatenate(outs, axis=-1) * scale.astype(jnp.float32)).astype(z.dtype)


def conformer_conv(z, dw_w, dw_b, ln_g, ln_b):
    val, gate = jnp.split(z, 2, axis=-1)
    h = val * jax.nn.sigmoid(gate)
    h = causal_dwconv(h, dw_w) + dw_b
    h = layer_norm(h, ln_g, ln_b)
    return jax.nn.silu(h)


def ssm_mixer(u, lam_re, lam_im, log_dt, b_re, b_im, c_re, c_im, d, w_glu, b_glu):
    bsz, s, _ = u.shape
    f32 = jnp.float32
    uf = u.astype(f32).reshape(bsz, s, SSM_GROUPS, SSM_CH)
    lam = lax.complex(lam_re.astype(f32), lam_im.astype(f32))
    dt = jnp.exp(log_dt.astype(f32))[:, None]
    lam_bar = jnp.exp(lam * dt)
    bmat = lax.complex(b_re.astype(f32), b_im.astype(f32))
    b_bar = ((lam_bar - 1.0) / lam)[..., None] * bmat
    bu = jnp.einsum('gph,bsgh->bsgp', b_bar, uf)
    a = jnp.broadcast_to(lam_bar, (1, s) + lam_bar.shape)

    def combine(e1, e2):
        a1, b1 = e1
        a2, b2 = e2
        return a1 * a2, a2 * b1 + b2

    _, states = lax.associative_scan(combine, (a, bu), axis=1)
    cmat = lax.complex(c_re.astype(f32), c_im.astype(f32))
    y = jnp.real(jnp.einsum('ghp,bsgp->bsgh', cmat, states)) + d.astype(f32).reshape(SSM_GROUPS, SSM_CH) * uf
    y = y.reshape(bsz, s, GROUP_WIDTH)
    yg = jax.nn.gelu(y)
    out = yg * jax.nn.sigmoid(yg @ w_glu.astype(f32) + b_glu.astype(f32))
    return out.astype(u.dtype)


def setup_inputs(seed: int = 0) -> dict:
    key = jax.random.key(seed)
    ks = jax.random.split(key, 32)
    L = DEPTH
    f32 = jnp.float32

    def nrm(k, shape, scale):
        return jax.random.normal(k, shape, f32) * scale

    lam_im_base = jnp.pi * jnp.arange(SSM_STATE, dtype=f32)
    return {
        "x": nrm(ks[0], (BATCH, SEQ, D_MODEL), 1.0),
        "c": nrm(ks[1], (BATCH, D_MODEL), 1.0),
        "w_ada": nrm(ks[2], (L, D_MODEL, 6 * D_MODEL), 0.1 * D_MODEL ** -0.5),
        "b_ada": nrm(ks[3], (L, 6 * D_MODEL), 0.01),
        "w_in": nrm(ks[4], (L, D_MODEL, IN_WIDTH), D_MODEL ** -0.5),
        "b_in": nrm(ks[5], (L, IN_WIDTH), 0.01),
        "sc_w": nrm(ks[6], (L, SC_TAPS, GROUP_WIDTH), SC_TAPS ** -0.5),
        "pool_w": nrm(ks[7], (L, len(POOL_WINDOWS), POOL_GROUP, POOL_GROUP), POOL_GROUP ** -0.5),
        "pool_scale": 1.0 + nrm(ks[8], (L, GROUP_WIDTH), 0.02),
        "cf_dw_w": nrm(ks[9], (L, CF_TAPS, GROUP_WIDTH), CF_TAPS ** -0.5),
        "cf_dw_b": nrm(ks[10], (L, GROUP_WIDTH), 0.01),
        "cf_ln_g": 1.0 + nrm(ks[11], (L, GROUP_WIDTH), 0.02),
        "cf_ln_b": nrm(ks[12], (L, GROUP_WIDTH), 0.01),
        "ssm_lam_re": -0.5 + nrm(ks[13], (L, SSM_GROUPS, SSM_STATE), 0.01),
        "ssm_lam_im": lam_im_base + nrm(ks[14], (L, SSM_GROUPS, SSM_STATE), 0.01),
        "ssm_log_dt": jax.random.uniform(ks[15], (L, SSM_GROUPS), f32, math.log(SSM_DT_MIN), math.log(SSM_DT_MAX)),
        "ssm_b_re": nrm(ks[16], (L, SSM_GROUPS, SSM_STATE, SSM_CH), (2 * SSM_CH) ** -0.5),
        "ssm_b_im": nrm(ks[17], (L, SSM_GROUPS, SSM_STATE, SSM_CH), (2 * SSM_CH) ** -0.5),
        "ssm_c_re": nrm(ks[18], (L, SSM_GROUPS, SSM_CH, SSM_STATE), SSM_STATE ** -0.5),
        "ssm_c_im": nrm(ks[19], (L, SSM_GROUPS, SSM_CH, SSM_STATE), SSM_STATE ** -0.5),
        "ssm_d": nrm(ks[20], (L, GROUP_WIDTH), 1.0),
        "ssm_w_glu": nrm(ks[21], (L, GROUP_WIDTH, GROUP_WIDTH), GROUP_WIDTH ** -0.5),
        "ssm_b_glu": nrm(ks[22], (L, GROUP_WIDTH), 0.01),
        "w_o": nrm(ks[23], (L, MIX_WIDTH, D_MODEL), BETA * MIX_WIDTH ** -0.5),
        "ln1_g": 1.0 + nrm(ks[24], (L, D_MODEL), 0.02),
        "ln1_b": nrm(ks[25], (L, D_MODEL), 0.01),
        "w_gate": nrm(ks[26], (L, D_MODEL, D_FF), D_MODEL ** -0.5),
        "w_up": nrm(ks[27], (L, D_MODEL, D_FF), D_MODEL ** -0.5),
        "w_down": nrm(ks[28], (L, D_FF, D_MODEL), BETA * D_FF ** -0.5),
        "ln2_g": 1.0 + nrm(ks[29], (L, D_MODEL), 0.02),
        "ln2_b": nrm(ks[30], (L, D_MODEL), 0.01),
    }


def reference(x, c, w_ada, b_ada, w_in, b_in, sc_w, pool_w, pool_scale, cf_dw_w, cf_dw_b, cf_ln_g, cf_ln_b,
              ssm_lam_re, ssm_lam_im, ssm_log_dt, ssm_b_re, ssm_b_im, ssm_c_re, ssm_c_im, ssm_d,
              ssm_w_glu, ssm_b_glu, w_o, ln1_g, ln1_b, w_gate, w_up, w_down, ln2_g, ln2_b):
    cond = jax.nn.silu(c)
    for l in range(DEPTH):
        mod = cond @ w_ada[l] + b_ada[l]
        sh1, sc1, g1, sh2, sc2, g2 = [m[:, None, :] for m in jnp.split(mod, 6, axis=-1)]

        h = x * (1 + sc1) + sh1
        z = h @ w_in[l] + b_in[l]
        z_h, z_b, z_c, z_p, z_cv, z_cg, z_s = jnp.split(z, IN_SPLITS, axis=-1)
        y_a = z_b * causal_dwconv(z_c * z_h, sc_w[l])
        y_b = pool_mixer(z_p, pool_w[l], pool_scale[l])
        y_c = conformer_conv(jnp.concatenate([z_cv, z_cg], axis=-1),
                             cf_dw_w[l], cf_dw_b[l], cf_ln_g[l], cf_ln_b[l])
        y_d = ssm_mixer(z_s, ssm_lam_re[l], ssm_lam_im[l], ssm_log_dt[l], ssm_b_re[l], ssm_b_im[l],
                        ssm_c_re[l], ssm_c_im[l], ssm_d[l], ssm_w_glu[l], ssm_b_glu[l])
        y = jnp.concatenate([y_a, y_b, y_c, y_d], axis=-1) @ w_o[l]
        x = layer_norm(ALPHA * x + (1 + g1) * y, ln1_g[l], ln1_b[l])

        h = x * (1 + sc2) + sh2
        f = (jax.nn.silu(h @ w_gate[l]) * (h @ w_up[l])) @ w_down[l]
        x = layer_norm(ALPHA * x + (1 + g2) * f, ln2_g[l], ln2_b[l])
    return x
```

```cpp
#include <hip/hip_runtime.h>
#include <hip/hip_cooperative_groups.h>
#include <cstdio>
#include <cstdint>
namespace cg = cooperative_groups;

#define LAS __attribute__((address_space(3)))
typedef unsigned short bf16_t;
typedef short bf16x8 __attribute__((ext_vector_type(8)));
typedef float f32x4 __attribute__((ext_vector_type(4)));
typedef float f32x2 __attribute__((ext_vector_type(2)));
typedef unsigned u32x4 __attribute__((ext_vector_type(4)));
typedef unsigned u32x2 __attribute__((ext_vector_type(2)));

constexpr int DM = 1024, NB = 8, SEQ = 8192, MTOK = NB * SEQ, DEPTH = 4, FF = 2816, INW = 1792, ZW = 1024;
constexpr int CT = 32, NCH = SEQ / CT, NBC = NB * NCH, KSSM = 640;
constexpr float ALPHA = 1.681792830507429f;
constexpr float LN_EPS = 1e-5f;
constexpr int NTHREADS = 512, GRID = 256;
constexpr unsigned AMP_MASK = 0u;
constexpr int REP_MIX = 1, REP_P6 = 1;

constexpr size_t MiB = 1u << 20;
constexpr size_t WS_CTL = 0, CTL_BYTES = 1 * MiB;
constexpr size_t WS_XCH = 1 * MiB;
constexpr size_t WS_MOD = 3 * MiB;
constexpr size_t WS_PW = 4 * MiB;
constexpr size_t WS_BBAR = 6 * MiB;
constexpr size_t WS_KK = 7 * MiB;
constexpr size_t WS_WIN = 10 * MiB;
constexpr size_t WS_WO = 24 * MiB;
constexpr size_t WS_WGU = 32 * MiB;
constexpr size_t WS_WDN = 76 * MiB;
constexpr size_t WS_WGLU = 98 * MiB;
constexpr size_t WS_BTOUT = 100 * MiB;
constexpr size_t WS_W1 = 140 * MiB;
constexpr size_t WS_HMOD = 156 * MiB;
constexpr size_t WS_ZMAIN = 284 * MiB;
constexpr size_t WS_APR = 476 * MiB;
constexpr size_t WS_S = 516 * MiB;
constexpr size_t WS_YG = 532 * MiB;
constexpr size_t WS_YMIX = 564 * MiB;
constexpr size_t WS_HID = 284 * MiB;
constexpr size_t WS_END = 692 * MiB;
constexpr int CW_TMO = 0, CW_CNT = 1024, CW_XB = 32768;

constexpr int LDS_BYTES = 147456;

__device__ __forceinline__ unsigned cvt_pk_bf16(float lo, float hi) { unsigned r; asm volatile("v_cvt_pk_bf16_f32 %0, %1, %2" : "=v"(r) : "v"(lo), "v"(hi)); return r; }
__device__ __forceinline__ void ld8(const bf16_t* p, float (&f)[8]) {
    const u32x4 w = *(const u32x4*)p;
    f[0] = __uint_as_float(w.x << 16); f[1] = __uint_as_float(w.x & 0xffff0000u);
    f[2] = __uint_as_float(w.y << 16); f[3] = __uint_as_float(w.y & 0xffff0000u);
    f[4] = __uint_as_float(w.z << 16); f[5] = __uint_as_float(w.z & 0xffff0000u);
    f[6] = __uint_as_float(w.w << 16); f[7] = __uint_as_float(w.w & 0xffff0000u);
}
__device__ __forceinline__ void st8(bf16_t* p, const float (&f)[8]) {
    u32x4 w; w.x = cvt_pk_bf16(f[0], f[1]); w.y = cvt_pk_bf16(f[2], f[3]); w.z = cvt_pk_bf16(f[4], f[5]); w.w = cvt_pk_bf16(f[6], f[7]);
    *(u32x4*)p = w;
}
__device__ __forceinline__ float sigmoidf_(float a) { return __builtin_amdgcn_rcpf(1.0f + __expf(-a)); }
__device__ __forceinline__ float siluf_(float a) { return a * sigmoidf_(a); }
__device__ __forceinline__ float gelu_tanh_(float v) { const float u = 0.7978845608028654f * (v + 0.044715f * v * v * v); return v * sigmoidf_(2.0f * u); }
__device__ __forceinline__ int fresh_lane() { int l; asm volatile("v_mbcnt_lo_u32_b32 %0, -1, 0\n\tv_mbcnt_hi_u32_b32 %0, -1, %0" : "=v"(l)); return l; }
__device__ __forceinline__ float shfl_xor_l(float v, int o, int lane) { return __int_as_float(__builtin_amdgcn_ds_bpermute((lane ^ o) << 2, __float_as_int(v))); }
__device__ __forceinline__ float wave_sum(float v, int lane) {
#pragma unroll
    for (int o = 1; o < 64; o <<= 1) v += shfl_xor_l(v, o, lane);
    return v;
}

namespace pg8 {
constexpr int BM = 256, BK = 64, HALF = 128, HTB = HALF * BK * 2, STAGE_BYTES = 8 * HTB, NXCD = 8, WGM = 8;
__host__ __device__ __forceinline__ int lds_byte(int r, int c) { const int st = (r >> 4) * 2 + (c >> 5), rr = r & 15, cc = c & 31, ob = rr * 64 + cc * 2; return st * 1024 + (ob ^ (((ob >> 9) & 1) << 5)); }
__host__ __device__ __forceinline__ void stage_rc(int b, int& R, int& C) { const int st = b / 1024, sb = b % 1024, swz = sb ^ (((sb >> 9) & 1) << 5); R = (st >> 1) * 16 + swz / 64; C = (st & 1) * 32 + (swz % 64) / 2; }
__host__ __device__ __forceinline__ int perm32(int rho) { const int n = rho >> 4, i = rho & 15; return 8 * (i >> 2) + 4 * n + (i & 3); }

struct Unit { int pm, pn; };
struct Gemm { const bf16_t* A; const bf16_t* Bt; int K, lda, ldb; };

struct StaticOrder {
    int nM, nN, nwg, G, c;
    __device__ void init(int M, int N, int G_, int c_) { nM = M / BM; nN = N / BM; nwg = nM * nN; G = G_; c = c_; }
    __device__ bool next(int i, Unit& u) const {
        const long L = (long)i * G + c; if (L >= nwg) return false;
        int wgid = (int)L; { const int q = nwg / NXCD, r = nwg % NXCD, xcd = wgid % NXCD, off = wgid / NXCD; wgid = (xcd < r ? xcd * (q + 1) : r * (q + 1) + (xcd - r) * q) + off; }
        const int nig = WGM * nN, gid = wgid / nig, fm = gid * WGM, gsz = (nM - fm) < WGM ? (nM - fm) : WGM;
        u.pm = fm + ((wgid % nig) % gsz); u.pn = (wgid % nig) / gsz; return true;
    }
};
struct RoundOrder {
    int xcd, slot;
    __device__ bool next(int i, Unit& u) const { if (i >= 4) return false; u.pm = i * 64 + xcd * 8 + (slot >> 2); u.pn = slot & 3; return true; }
};
struct PairOrder {
    int pm, pn0;
    __device__ bool next(int i, Unit& u) const { if (i >= 2) return false; u.pm = pm; u.pn = pn0 + i; return true; }
};
struct OneUnit {
    int pm, pn; bool valid;
    __device__ bool next(int i, Unit& u) const { if (i != 0 || !valid) return false; u.pm = pm; u.pn = pn; return true; }
};

template <class Epi, class Sched, bool ALIGN_EPI>
__device__ __forceinline__ void gemm_phase(LAS unsigned char* lds, const Gemm g, const Sched& S, const Epi& E, int wid) {
    asm volatile("" : "+s"(wid));
    const int wr = wid >> 2, wc = wid & 3; int fr = 0, fq = 0;
    const int K = g.K, nt = K / BK;
    unsigned voffA[2], voffB[2]; int aoff, boff;
#define PG8_LANE_CONSTS() do { const int lane_ = fresh_lane(), tid_ = wid * 64 + lane_; fr = lane_ & 15; fq = lane_ >> 4; \
        _Pragma("unroll") for (int i = 0; i < 2; ++i) { int R, C; stage_rc(tid_ * 16 + i * 8192, R, C); const int Rb = Epi::PERM ? ((R & ~31) + perm32(R & 31)) : R; \
            voffA[i] = (unsigned)(R * g.lda + C) * 2u; voffB[i] = (unsigned)(Rb * g.ldb + C) * 2u; } \
        aoff = lds_byte(wr * 64 + fr, fq * 8); boff = lds_byte(wc * 32 + fr, fq * 8); } while (0)
    PG8_LANE_CONSTS();
    const size_t kstep = (size_t)(BK * 2);
    const size_t hstepA = (size_t)HALF * g.lda * 2, hstepB = (size_t)HALF * g.ldb * 2;
    const size_t tstepA = 2 * hstepA, tstepB = 2 * hstepB;
    const unsigned ldsw = (unsigned)wid * 1024u;
#define PG8_SA(b, h) (((b) * 2 + (h)) * HTB)
#define PG8_SB(b, h) ((4 + (b) * 2 + (h)) * HTB)
#define PG8_STAGE(bufoff, gbase, voff) do { _Pragma("unroll") for (int _i = 0; _i < 2; ++_i) \
        __builtin_amdgcn_global_load_lds((const unsigned*)((const char*)(gbase) + (voff)[_i]), (LAS unsigned*)(lds + (bufoff) + ldsw + _i * 8192), 16, 0, 0); } while (0)
#define PG8_LDA(dst, b, h) do { _Pragma("unroll") for (int m = 0; m < 4; ++m) _Pragma("unroll") for (int k = 0; k < 2; ++k) dst[m][k] = *(const LAS bf16x8*)(lds + PG8_SA(b, h) + aoff + m * 2048 + k * 1024); } while (0)
#define PG8_LDB(dst, b, h) do { _Pragma("unroll") for (int n = 0; n < 2; ++n) _Pragma("unroll") for (int k = 0; k < 2; ++k) dst[n][k] = *(const LAS bf16x8*)(lds + PG8_SB(b, h) + boff + n * 2048 + k * 1024); } while (0)
#define PG8_MMA(ai, bj, At, Bt) do { __builtin_amdgcn_s_setprio(1); _Pragma("unroll") for (int m = 0; m < 4; ++m) _Pragma("unroll") for (int n = 0; n < 2; ++n) _Pragma("unroll") for (int k = 0; k < 2; ++k) \
        acc[ai][bj][m][n] = __builtin_amdgcn_mfma_f32_16x16x32_bf16(Bt[n][k], At[m][k], acc[ai][bj][m][n], 0, 0, 0); __builtin_amdgcn_s_setprio(0); } while (0)
#define PG8_WAIT_V(n) asm volatile("s_waitcnt vmcnt(" #n ")" ::: "memory")
#define PG8_WAIT_L(n) asm volatile("s_waitcnt lgkmcnt(" #n ")" ::: "memory")
#define PG8_BAR __builtin_amdgcn_s_barrier()
#define PG8_SCHED __builtin_amdgcn_sched_barrier(0)
    Unit cur, nxt; int ui = 0;
    if (!S.next(0, cur)) return;
    f32x4 acc[2][2][4][2];
#pragma unroll
    for (int a = 0; a < 2; ++a)
#pragma unroll
        for (int b = 0; b < 2; ++b)
#pragma unroll
            for (int m = 0; m < 4; ++m)
#pragma unroll
                for (int n = 0; n < 2; ++n) acc[a][b][m][n] = (f32x4){0.f, 0.f, 0.f, 0.f};
    bf16x8 At[4][2], B0[2][2], B1[2][2];
    const char* cA = (const char*)g.A + (size_t)cur.pm * tstepA; const char* cB = (const char*)g.Bt + (size_t)cur.pn * tstepB;
    PG8_STAGE(PG8_SB(0, 0), cB, voffB); PG8_STAGE(PG8_SB(0, 1), cB + hstepB, voffB); PG8_STAGE(PG8_SA(0, 0), cA, voffA); PG8_STAGE(PG8_SA(0, 1), cA + hstepA, voffA);
    if (wr == 1) PG8_BAR;
    PG8_WAIT_V(2); PG8_BAR;
    PG8_STAGE(PG8_SB(1, 0), cB + kstep, voffB); PG8_STAGE(PG8_SA(1, 0), cA + kstep, voffA); PG8_STAGE(PG8_SB(1, 1), cB + hstepB + kstep, voffB);
    PG8_WAIT_V(6); PG8_BAR;
    for (;;) {
        PG8_LANE_CONSTS();
        const bool has_next = S.next(ui + 1, nxt);
        const char* nA = has_next ? (const char*)g.A + (size_t)nxt.pm * tstepA : cA; const char* nB = has_next ? (const char*)g.Bt + (size_t)nxt.pn * tstepB : cB;
        for (int t = 0; t < nt; t += 2) {
            const bool last = (t == nt - 2);
            const char* a1 = cA + (size_t)(t + 1) * kstep;
            const char* a2 = last ? nA : cA + (size_t)(t + 2) * kstep; const char* b2 = last ? nB : cB + (size_t)(t + 2) * kstep;
            const char* a3 = a2 + kstep; const char* b3 = b2 + kstep;
            PG8_LDB(B0, 0, 0); PG8_LDB(B1, 0, 1); PG8_SCHED; PG8_LDA(At, 0, 0); PG8_STAGE(PG8_SA(1, 1), a1 + hstepA, voffA);
            PG8_WAIT_V(8); PG8_WAIT_L(0); PG8_BAR; PG8_MMA(0, 0, At, B0); PG8_MMA(0, 1, At, B1); PG8_BAR; PG8_SCHED;
            PG8_LDA(At, 0, 1); PG8_STAGE(PG8_SB(0, 0), b2, voffB); PG8_STAGE(PG8_SB(0, 1), b2 + hstepB, voffB); PG8_STAGE(PG8_SA(0, 0), a2, voffA);
            PG8_WAIT_V(8); PG8_WAIT_L(0); PG8_BAR; PG8_MMA(1, 0, At, B0); PG8_MMA(1, 1, At, B1); PG8_BAR; PG8_SCHED;
            PG8_LDB(B0, 1, 0); PG8_LDB(B1, 1, 1); PG8_SCHED; PG8_LDA(At, 1, 0); PG8_STAGE(PG8_SA(0, 1), a2 + hstepA, voffA);
            PG8_WAIT_V(8); PG8_WAIT_L(0); PG8_BAR; PG8_MMA(0, 0, At, B0); PG8_MMA(0, 1, At, B1); PG8_BAR; PG8_SCHED;
            PG8_LDA(At, 1, 1); PG8_STAGE(PG8_SB(1, 0), b3, voffB); PG8_STAGE(PG8_SB(1, 1), b3 + hstepB, voffB); PG8_STAGE(PG8_SA(1, 0), a3, voffA);
            PG8_WAIT_V(8); PG8_WAIT_L(0); PG8_BAR; PG8_MMA(1, 0, At, B0); PG8_MMA(1, 1, At, B1); PG8_BAR; PG8_SCHED;
        }
        if constexpr (ALIGN_EPI) { if (wr == 0) PG8_BAR; }
        if constexpr (!Epi::AFTER_DRAIN) { E(acc, cur, wr, wc, fr, fq); }
        if (!has_next) break;
#pragma unroll
        for (int a = 0; a < 2; ++a)
#pragma unroll
            for (int b = 0; b < 2; ++b)
#pragma unroll
                for (int m = 0; m < 4; ++m)
#pragma unroll
                    for (int n = 0; n < 2; ++n) acc[a][b][m][n] = (f32x4){0.f, 0.f, 0.f, 0.f};
        cur = nxt; cA = nA; cB = nB; ++ui;
        if constexpr (ALIGN_EPI) { if (wr == 1) PG8_BAR; }
    }
    PG8_WAIT_V(0);
    if constexpr (!ALIGN_EPI) { if (wr == 0) PG8_BAR; }
    PG8_BAR;
    static_assert(!Epi::AFTER_DRAIN, "all epilogues run inline");
#undef PG8_LANE_CONSTS
#undef PG8_SA
#undef PG8_SB
#undef PG8_STAGE
#undef PG8_LDA
#undef PG8_LDB
#undef PG8_MMA
#undef PG8_WAIT_V
#undef PG8_WAIT_L
#undef PG8_BAR
#undef PG8_SCHED
}


struct EpiZ {
    static constexpr bool PERM = true, AFTER_DRAIN = false;
    bf16_t* zmain; bf16_t* apr; const float* bias;
    __device__ __forceinline__ void operator()(const f32x4 (&acc)[2][2][4][2], const Unit& u, int wr, int wc, int fr_, int fq_) const {
        const int ln_ = fresh_lane(), fr = ln_ & 15, fq = ln_ >> 4;
        int row0 = u.pm * BM + wr * 64 + fr, cl = wc * 32 + 8 * fq; asm volatile("" : "+v"(row0));
        const int pn = u.pn;
        if (pn == 2 || pn == 3 || pn == 6) {
            const int sbase = pn == 2 ? 256 : (pn == 3 ? 768 : 1536), obase = pn == 2 ? 256 : 512;
#pragma unroll
            for (int bj = 0; bj < 2; ++bj) {
                const int c = bj * HALF + cl;
                const f32x4 b0 = *(const f32x4*)(bias + sbase + c), b1 = *(const f32x4*)(bias + sbase + c + 4);
#pragma unroll
                for (int ai = 0; ai < 2; ++ai)
#pragma unroll
                    for (int m = 0; m < 4; ++m) {
                        const int row = row0 + ai * HALF + m * 16;
                        const f32x4 v0 = acc[ai][bj][m][0] + b0, v1 = acc[ai][bj][m][1] + b1;
                        u32x4 w; w.x = cvt_pk_bf16(v0[0], v0[1]); w.y = cvt_pk_bf16(v0[2], v0[3]); w.z = cvt_pk_bf16(v1[0], v1[1]); w.w = cvt_pk_bf16(v1[2], v1[3]);
                        if (pn != 6) *(u32x4*)(zmain + (size_t)row * ZW + obase + c) = w;
                        else { const int gq = c >> 4, h0 = c & 15;
                            *(u32x4*)(apr + ((size_t)(gq * NBC + (row >> 5)) * KSSM + (row & 31) * 16 + h0)) = w; }
                    }
            }
        } else {
            const bool glu = pn >= 4; const int hc = (pn & 1) * HALF + cl;
            const int sa = glu ? 1024 : 0, sb = glu ? 1280 : 512, obase = glu ? 768 : 0;
            const f32x4 a0 = *(const f32x4*)(bias + sa + hc), a1 = *(const f32x4*)(bias + sa + hc + 4), c0 = *(const f32x4*)(bias + sb + hc), c1 = *(const f32x4*)(bias + sb + hc + 4);
#pragma unroll
            for (int ai = 0; ai < 2; ++ai)
#pragma unroll
                for (int m = 0; m < 4; ++m) {
                    const int row = row0 + ai * HALF + m * 16;
                    const f32x4 x0 = acc[ai][0][m][0] + a0, x1 = acc[ai][0][m][1] + a1, y0 = acc[ai][1][m][0] + c0, y1 = acc[ai][1][m][1] + c1;
                    float o[8];
                    if (glu) { o[0] = x0[0] * sigmoidf_(y0[0]); o[1] = x0[1] * sigmoidf_(y0[1]); o[2] = x0[2] * sigmoidf_(y0[2]); o[3] = x0[3] * sigmoidf_(y0[3]);
                               o[4] = x1[0] * sigmoidf_(y1[0]); o[5] = x1[1] * sigmoidf_(y1[1]); o[6] = x1[2] * sigmoidf_(y1[2]); o[7] = x1[3] * sigmoidf_(y1[3]); }
                    else { o[0] = x0[0] * y0[0]; o[1] = x0[1] * y0[1]; o[2] = x0[2] * y0[2]; o[3] = x0[3] * y0[3]; o[4] = x1[0] * y1[0]; o[5] = x1[1] * y1[1]; o[6] = x1[2] * y1[2]; o[7] = x1[3] * y1[3]; }
                    st8(zmain + (size_t)row * ZW + obase + hc, o);
                }
        }
    }
};
struct EpiStates {
    static constexpr bool PERM = false, AFTER_DRAIN = false;
    float* S;
    __device__ __forceinline__ void operator()(const f32x4 (&acc)[2][2][4][2], const Unit& u, int wr, int wc, int fr_, int fq_) const {
        const int ln_ = fresh_lane(), fr = ln_ & 15, fq = ln_ >> 4;
        int row0 = u.pm * BM + wr * 64 + fr, c0 = wc * 32 + 4 * fq; asm volatile("" : "+v"(row0));
#pragma unroll
        for (int ai = 0; ai < 2; ++ai)
#pragma unroll
            for (int m = 0; m < 4; ++m)
#pragma unroll
                for (int n = 0; n < 2; ++n) *(f32x4*)(S + (size_t)(row0 + ai * HALF + m * 16) * 128 + c0 + n * 16) = acc[ai][0][m][n];
    }
};
struct EpiSsmOut {
    static constexpr bool PERM = true, AFTER_DRAIN = false;
    bf16_t* yg;
    __device__ __forceinline__ void operator()(const f32x4 (&acc)[2][2][4][2], const Unit& u, int wr, int wc, int fr_, int fq_) const {
        const int ln_ = fresh_lane(), fr = ln_ & 15, fq = ln_ >> 4;
        const int gq = u.pn >> 1; int R0 = u.pm * BM + wr * 64 + fr; asm volatile("" : "+v"(R0));
#pragma unroll
        for (int bj = 0; bj < 2; ++bj) {
            const int lc = (u.pn & 1) * 256 + bj * HALF + wc * 32 + 8 * fq, t = lc >> 4, h0 = lc & 15;
#pragma unroll
            for (int ai = 0; ai < 2; ++ai)
#pragma unroll
                for (int m = 0; m < 4; ++m) {
                    const int R = R0 + ai * HALF + m * 16, bc = R & (NBC - 1);
                    const f32x4 v0 = acc[ai][bj][m][0], v1 = acc[ai][bj][m][1];
                    u32x4 w; w.x = cvt_pk_bf16(gelu_tanh_(v0[0]), gelu_tanh_(v0[1])); w.y = cvt_pk_bf16(gelu_tanh_(v0[2]), gelu_tanh_(v0[3]));
                    w.z = cvt_pk_bf16(gelu_tanh_(v1[0]), gelu_tanh_(v1[1])); w.w = cvt_pk_bf16(gelu_tanh_(v1[2]), gelu_tanh_(v1[3]));
                    *(u32x4*)(yg + (size_t)(bc * CT + t) * 256 + gq * 16 + h0) = w;
                }
        }
    }
};
struct EpiGlu {
    static constexpr bool PERM = true, AFTER_DRAIN = false;
    const bf16_t* yg; bf16_t* ymix; const float* bias;
    __device__ __forceinline__ void operator()(const f32x4 (&acc)[2][2][4][2], const Unit& u, int wr, int wc, int fr_, int fq_) const {
        const int ln_ = fresh_lane(), fr = ln_ & 15, fq = ln_ >> 4;
        int row0 = u.pm * BM + wr * 64 + fr, cl = wc * 32 + 8 * fq; asm volatile("" : "+v"(row0));
#pragma unroll
        for (int bj = 0; bj < 2; ++bj) {
            const int c = bj * HALF + cl;
            const f32x4 b0 = *(const f32x4*)(bias + c), b1 = *(const f32x4*)(bias + c + 4);
            u32x4 yv[2][4];
#pragma unroll
            for (int ai = 0; ai < 2; ++ai)
#pragma unroll
                for (int m = 0; m < 4; ++m) yv[ai][m] = *(const u32x4*)(yg + (size_t)(row0 + ai * HALF + m * 16) * 256 + c);
#pragma unroll
            for (int ai = 0; ai < 2; ++ai)
#pragma unroll
                for (int m = 0; m < 4; ++m) {
                    const int row = row0 + ai * HALF + m * 16; const u32x4 w = yv[ai][m];
                    const f32x4 v0 = acc[ai][bj][m][0] + b0, v1 = acc[ai][bj][m][1] + b1;
                    float o[8];
                    o[0] = __uint_as_float(w.x << 16) * sigmoidf_(v0[0]); o[1] = __uint_as_float(w.x & 0xffff0000u) * sigmoidf_(v0[1]);
                    o[2] = __uint_as_float(w.y << 16) * sigmoidf_(v0[2]); o[3] = __uint_as_float(w.y & 0xffff0000u) * sigmoidf_(v0[3]);
                    o[4] = __uint_as_float(w.z << 16) * sigmoidf_(v1[0]); o[5] = __uint_as_float(w.z & 0xffff0000u) * sigmoidf_(v1[1]);
                    o[6] = __uint_as_float(w.w << 16) * sigmoidf_(v1[2]); o[7] = __uint_as_float(w.w & 0xffff0000u) * sigmoidf_(v1[3]);
                    st8(ymix + (size_t)row * DM + 768 + c, o);
                }
            asm volatile("" ::: "memory");
        }
    }
};
struct EpiSwiGlu {
    static constexpr bool PERM = true, AFTER_DRAIN = false;
    bf16_t* hid;
    __device__ __forceinline__ void operator()(const f32x4 (&acc)[2][2][4][2], const Unit& u, int wr, int wc, int fr_, int fq_) const {
        const int ln_ = fresh_lane(), fr = ln_ & 15, fq = ln_ >> 4;
        int row0 = u.pm * BM + wr * 64 + fr, c = u.pn * HALF + wc * 32 + 8 * fq; asm volatile("" : "+v"(row0));
#pragma unroll
        for (int ai = 0; ai < 2; ++ai)
#pragma unroll
            for (int m = 0; m < 4; ++m) {
                const int row = row0 + ai * HALF + m * 16;
                const f32x4 g0 = acc[ai][0][m][0], g1 = acc[ai][0][m][1], u0 = acc[ai][1][m][0], u1 = acc[ai][1][m][1];
                const f32x4 t0 = g0 * (-1.4426950408889634f), t1 = g1 * (-1.4426950408889634f);
                const f32x4 d0 = (f32x4){__builtin_amdgcn_exp2f(t0[0]), __builtin_amdgcn_exp2f(t0[1]), __builtin_amdgcn_exp2f(t0[2]), __builtin_amdgcn_exp2f(t0[3])} + 1.0f;
                const f32x4 d1 = (f32x4){__builtin_amdgcn_exp2f(t1[0]), __builtin_amdgcn_exp2f(t1[1]), __builtin_amdgcn_exp2f(t1[2]), __builtin_amdgcn_exp2f(t1[3])} + 1.0f;
                const f32x4 r0 = (f32x4){__builtin_amdgcn_rcpf(d0[0]), __builtin_amdgcn_rcpf(d0[1]), __builtin_amdgcn_rcpf(d0[2]), __builtin_amdgcn_rcpf(d0[3])};
                const f32x4 r1 = (f32x4){__builtin_amdgcn_rcpf(d1[0]), __builtin_amdgcn_rcpf(d1[1]), __builtin_amdgcn_rcpf(d1[2]), __builtin_amdgcn_rcpf(d1[3])};
                const f32x4 o0 = (g0 * r0) * u0, o1 = (g1 * r1) * u1;
                u32x4 w; w.x = cvt_pk_bf16(o0[0], o0[1]); w.y = cvt_pk_bf16(o0[2], o0[3]); w.z = cvt_pk_bf16(o1[0], o1[1]); w.w = cvt_pk_bf16(o1[2], o1[3]);
                __builtin_nontemporal_store(w, (u32x4*)(hid + (size_t)row * FF + c));
            }
    }
};
struct EpiLn {
    static constexpr bool PERM = false, AFTER_DRAIN = false;
    float* xout; bf16_t* h; const float* gain; const float* psc; const float* psh; const float* lng; const float* lnb; const float* hsc; const float* hsh;
    unsigned long long* xbuf; unsigned* tmo; unsigned tag; LAS unsigned char* xl;
    __device__ __forceinline__ void operator()(f32x4 (&acc)[2][2][4][2], const Unit& u, int wr, int wc, int fr_, int fq_) const {
        const int wid = wr * 4 + wc; LAS unsigned char* lds = xl;
        const int lane = fresh_lane(), fr = lane & 15, fq = lane >> 4;
        const int b = u.pm >> 5;
        const int col0 = u.pn * BM + wc * 32 + 4 * fq;
        int rloc = wr * 64 + fr; asm volatile("" : "+v"(rloc));
#pragma unroll
        for (int bj = 0; bj < 2; ++bj) {
            f32x4 gv[2], pa[2], pb[2]; u32x2 hv[2][2][4];
#pragma unroll
            for (int n = 0; n < 2; ++n) {
                const int col = col0 + bj * HALF + n * 16;
                gv[n] = *(const f32x4*)(gain + b * 6144 + col); pa[n] = *(const f32x4*)(psc + b * 6144 + col); pb[n] = *(const f32x4*)(psh + b * 6144 + col);
#pragma unroll
                for (int ai = 0; ai < 2; ++ai)
#pragma unroll
                    for (int m = 0; m < 4; ++m) hv[n][ai][m] = *(const u32x2*)(h + (size_t)(u.pm * BM + rloc + ai * HALF + m * 16) * DM + col);
            }
#pragma unroll
            for (int n = 0; n < 2; ++n) {
                gv[n] = gv[n] + 1.0f; const f32x4 pd = pa[n] + 1.0f;
                pa[n] = (f32x4){ALPHA / pd[0], ALPHA / pd[1], ALPHA / pd[2], ALPHA / pd[3]};
#pragma unroll
                for (int ai = 0; ai < 2; ++ai)
#pragma unroll
                    for (int m = 0; m < 4; ++m) {
                        const u32x2 w = hv[n][ai][m];
                        const f32x4 hx = (f32x4){__uint_as_float(w.x << 16), __uint_as_float(w.x & 0xffff0000u), __uint_as_float(w.y << 16), __uint_as_float(w.y & 0xffff0000u)};
                        acc[ai][bj][m][n] = (hx - pb[n]) * pa[n] + gv[n] * acc[ai][bj][m][n];
                        asm volatile("" : "+v"(acc[ai][bj][m][n]));
                    }
            }
            asm volatile("" ::: "memory");
        }
        f32x4 oa[2][2], ob[2][2];
#pragma unroll
        for (int bj = 0; bj < 2; ++bj)
#pragma unroll
            for (int n = 0; n < 2; ++n) {
                const int col = col0 + bj * HALF + n * 16;
                oa[bj][n] = *(const f32x4*)(lng + col); ob[bj][n] = *(const f32x4*)(lnb + col);
                if (!xout) { const f32x4 ha = *(const f32x4*)(hsc + b * 6144 + col) + 1.0f, hb = *(const f32x4*)(hsh + b * 6144 + col); oa[bj][n] = oa[bj][n] * ha; ob[bj][n] = ob[bj][n] * ha + hb; }
            }
        LAS f32x2* P = (LAS f32x2*)lds;
        LAS f32x2* Sx = (LAS f32x2*)(lds + 8192);
        LAS unsigned* flag = (LAS unsigned*)(lds + 8192 + 2048);
#pragma unroll
        for (int ai = 0; ai < 2; ++ai)
#pragma unroll
            for (int m = 0; m < 4; ++m) {
                float s = 0.f;
#pragma unroll
                for (int bj = 0; bj < 2; ++bj)
#pragma unroll
                    for (int n = 0; n < 2; ++n) { const f32x4 v = acc[ai][bj][m][n]; s += (v[0] + v[1]) + (v[2] + v[3]); }
                s += shfl_xor_l(s, 16, lane); s += shfl_xor_l(s, 32, lane);
                const float mw = s * (1.0f / 64.0f); float q = 0.f;
#pragma unroll
                for (int bj = 0; bj < 2; ++bj)
#pragma unroll
                    for (int n = 0; n < 2; ++n) { const f32x4 d = acc[ai][bj][m][n] - mw; q += (d[0] * d[0] + d[1] * d[1]) + (d[2] * d[2] + d[3] * d[3]); }
                q += shfl_xor_l(q, 16, lane); q += shfl_xor_l(q, 32, lane);
                if (fq == 0) P[(ai * HALF + rloc + m * 16) * 4 + wc] = (f32x2){mw, q};
            }
        asm volatile("s_waitcnt lgkmcnt(0)" ::: "memory"); __builtin_amdgcn_s_barrier(); asm volatile("" ::: "memory");
        const int row = wid * 32 + (lane & 31);
        if (lane < 32) {
            const f32x2 a = P[row * 4 + 0], bq = P[row * 4 + 1], c = P[row * 4 + 2], d = P[row * 4 + 3];
            const float mt0 = (a.x + bq.x + c.x + d.x) * 0.25f;
            const float da = a.x - mt0, db = bq.x - mt0, dc = c.x - mt0, dd = d.x - mt0;
            const float m20 = (a.y + bq.y) + (c.y + d.y) + 64.0f * ((da * da + db * db) + (dc * dc + dd * dd));
            unsigned long long* slot = xbuf + (size_t)(u.pm * BM + row) * 4;
            __hip_atomic_store(slot + u.pn, ((unsigned long long)((__float_as_uint(m20) & ~7u) | tag) << 32) | __float_as_uint(mt0), __ATOMIC_RELAXED, __HIP_MEMORY_SCOPE_AGENT);
            unsigned long long w0, w1, w2, w3; unsigned sp = 0;
            for (;;) {
                w0 = __hip_atomic_load(slot + 0, __ATOMIC_RELAXED, __HIP_MEMORY_SCOPE_AGENT); w1 = __hip_atomic_load(slot + 1, __ATOMIC_RELAXED, __HIP_MEMORY_SCOPE_AGENT);
                w2 = __hip_atomic_load(slot + 2, __ATOMIC_RELAXED, __HIP_MEMORY_SCOPE_AGENT); w3 = __hip_atomic_load(slot + 3, __ATOMIC_RELAXED, __HIP_MEMORY_SCOPE_AGENT);
                const unsigned t0 = (unsigned)(w0 >> 32) & 7u, t1 = (unsigned)(w1 >> 32) & 7u, t2 = (unsigned)(w2 >> 32) & 7u, t3 = (unsigned)(w3 >> 32) & 7u;
                if (t0 == tag && t1 == tag && t2 == tag && t3 == tag) break;
                if (++sp > (1u << 20)) { __hip_atomic_store(tmo, 1u, __ATOMIC_RELAXED, __HIP_MEMORY_SCOPE_AGENT); break; }
                __builtin_amdgcn_s_sleep(1);
            }
            const float mt[4] = {__uint_as_float((unsigned)w0), __uint_as_float((unsigned)w1), __uint_as_float((unsigned)w2), __uint_as_float((unsigned)w3)};
            const float m2[4] = {__uint_as_float((unsigned)(w0 >> 32) & ~7u), __uint_as_float((unsigned)(w1 >> 32) & ~7u), __uint_as_float((unsigned)(w2 >> 32) & ~7u), __uint_as_float((unsigned)(w3 >> 32) & ~7u)};
            const float mean = ((mt[0] + mt[1]) + (mt[2] + mt[3])) * 0.25f; float q = 0.f;
#pragma unroll
            for (int t = 0; t < 4; ++t) { const float dm = mt[t] - mean; q += m2[t] + 256.0f * dm * dm; }
            Sx[row] = (f32x2){mean, 1.0f / sqrtf(q * (1.0f / 1024.0f) + LN_EPS)};
        }
        asm volatile("s_waitcnt lgkmcnt(0)" ::: "memory"); __builtin_amdgcn_s_barrier(); asm volatile("" ::: "memory");
#pragma unroll
        for (int bj = 0; bj < 2; ++bj)
#pragma unroll
            for (int n = 0; n < 2; ++n) {
                const int col = col0 + bj * HALF + n * 16;
#pragma unroll
                for (int ai = 0; ai < 2; ++ai)
#pragma unroll
                    for (int m = 0; m < 4; ++m) {
                        const int r = ai * HALF + rloc + m * 16; const f32x2 sr = Sx[r];
                        const size_t off = (size_t)(u.pm * BM + r) * DM + col;
                        const f32x4 o = (acc[ai][bj][m][n] - sr.x) * sr.y * oa[bj][n] + ob[bj][n];
                        if (xout) *(f32x4*)(xout + off) = o;
                        else { u32x2 w; w.x = cvt_pk_bf16(o[0], o[1]); w.y = cvt_pk_bf16(o[2], o[3]); *(u32x2*)(h + off) = w; }
                    }
            }
    }
};
}

struct Args { const float* in[31]; float* out; unsigned char* ws; };
#define CAS __attribute__((address_space(4)))
__device__ __forceinline__ const CAS Args* fresh_args() { const CAS Args* p = (const CAS Args*)__builtin_amdgcn_kernarg_segment_ptr(); asm volatile("" : "+s"(p)); return p; }
#define PH_PTRS0 const int l_ = 0; PH_PTRS_(l_)
#define PH_PTRS PH_PTRS_(l)
#define PH_PTRS_(l) \
    const CAS Args* ka = fresh_args(); unsigned char* ws = ka->ws; \
    [[maybe_unused]] unsigned* ctl = (unsigned*)(ws + WS_CTL); [[maybe_unused]] float* mod = (float*)(ws + WS_MOD); \
    [[maybe_unused]] f32x2* pw = (f32x2*)(ws + WS_PW); [[maybe_unused]] f32x2* bbar = (f32x2*)(ws + WS_BBAR); [[maybe_unused]] float* Kk = (float*)(ws + WS_KK); \
    [[maybe_unused]] bf16_t* win_t = (bf16_t*)(ws + WS_WIN); [[maybe_unused]] bf16_t* wo_t = (bf16_t*)(ws + WS_WO); [[maybe_unused]] bf16_t* wgu_t = (bf16_t*)(ws + WS_WGU); \
    [[maybe_unused]] bf16_t* wdn_t = (bf16_t*)(ws + WS_WDN); [[maybe_unused]] bf16_t* wglu_t = (bf16_t*)(ws + WS_WGLU); \
    [[maybe_unused]] bf16_t* btout = (bf16_t*)(ws + WS_BTOUT); [[maybe_unused]] bf16_t* w1m = (bf16_t*)(ws + WS_W1); \
    [[maybe_unused]] bf16_t* hmod = (bf16_t*)(ws + WS_HMOD); [[maybe_unused]] bf16_t* zmain = (bf16_t*)(ws + WS_ZMAIN); [[maybe_unused]] bf16_t* apr = (bf16_t*)(ws + WS_APR); \
    [[maybe_unused]] float* Sst = (float*)(ws + WS_S); [[maybe_unused]] bf16_t* yg = (bf16_t*)(ws + WS_YG); [[maybe_unused]] bf16_t* ymix = (bf16_t*)(ws + WS_YMIX); [[maybe_unused]] bf16_t* hid = (bf16_t*)(ws + WS_HID); \
    [[maybe_unused]] float* xres = ka->out; [[maybe_unused]] const float* modl = mod + (size_t)l * 8 * 6144;

#define XB_TMO      128
#define XB_XCNT(j)  (256  + 64 * (j))
#define XB_XSUB(j)  (1280 + 64 * (j))
#define XB_XGEN(j)  (2304 + 64 * (j))
#define XB_TOP      3328
#define XB_TOPGEN   3392
#define XB_SPIN_CAP (1u << 18)
constexpr int XB_LDS_OFF = 131072 + 14336;
__device__ __forceinline__ unsigned xb_ld(unsigned* p)              { return __hip_atomic_load(p, __ATOMIC_RELAXED, __HIP_MEMORY_SCOPE_AGENT); }
__device__ __forceinline__ unsigned xb_add(unsigned* p, unsigned v) { return __hip_atomic_fetch_add(p, v, __ATOMIC_RELAXED, __HIP_MEMORY_SCOPE_AGENT); }
__device__ __forceinline__ unsigned xb_xcc_id() { return (unsigned)__builtin_amdgcn_s_getreg((3 << 11) | 20) & 0xFu; }
#define XB_SPIN(cond, bar) do { unsigned _sp = 0; while (cond) { __builtin_amdgcn_s_sleep(1); \
    if ((++_sp & 255u) == 0u) { if (xb_ld(&(bar)[XB_TMO])) break; if (_sp > XB_SPIN_CAP) { atomicAdd(&(bar)[XB_TMO], 1u); break; } } } } while (0)
__device__ __forceinline__ void xcd_barrier_complete(unsigned* bar, unsigned x, unsigned& nloc, unsigned& nx) {
    const unsigned G = (unsigned)GRID;
    unsigned sum, cnt, mine, sp = 0u;
    for (;;) {
        sum = 0u; cnt = 0u; mine = 0u;
#pragma unroll
        for (unsigned j = 0; j < 16; ++j) { const unsigned c = xb_ld(&bar[XB_XCNT(j)]); sum += c; cnt += (c > 0u) ? 1u : 0u; mine = (j == x) ? c : mine; }
        if (sum == G) break;
        __builtin_amdgcn_s_sleep(1);
        if ((++sp & 255u) == 0u) { if (xb_ld(&bar[XB_TMO])) break; if (sp > XB_SPIN_CAP) { atomicAdd(&bar[XB_TMO], 1u); break; } }
    }
    nloc = mine > 0u ? mine : 1u; nx = cnt > 0u ? cnt : 1u;
}
__device__ __forceinline__ void grid_bar(int wave, unsigned char* smem) {
    asm volatile("s_waitcnt vmcnt(0)" ::: "memory");
    __syncthreads();
    asm volatile("" : "+s"(wave));
    if (wave == 0 && fresh_lane() == 0) {
        const CAS Args* ka = fresh_args(); unsigned* bar = (unsigned*)(ka->ws + WS_CTL) + CW_XB;
        volatile LAS unsigned* st = (volatile LAS unsigned*)((LAS unsigned char*)smem + XB_LDS_OFF);
        const unsigned x = xb_xcc_id();
        __builtin_amdgcn_s_waitcnt(0);
        unsigned nloc = st[0], nx = st[1];
        if (nloc == 0u) { xcd_barrier_complete(bar, x, nloc, nx); st[0] = nloc; st[1] = nx; }
        const unsigned old = xb_add(&bar[XB_XSUB(x)], 1u);
        const unsigned gen = old / nloc;
        if (old + 1u == (gen + 1u) * nloc) {
            __builtin_amdgcn_fence(__ATOMIC_RELEASE, "agent");
            asm volatile("s_waitcnt vmcnt(0)" ::: "memory");
            const unsigned og = xb_add(&bar[XB_TOP], 1u);
            const unsigned tg = og / nx;
            if (og + 1u == (tg + 1u) * nx) xb_add(&bar[XB_TOPGEN], 1u);
            else XB_SPIN(xb_ld(&bar[XB_TOPGEN]) == tg, bar);
            __builtin_amdgcn_fence(__ATOMIC_ACQUIRE, "agent");
            xb_add(&bar[XB_XGEN(x)], 1u);
            asm volatile("s_waitcnt vmcnt(0)" ::: "memory");
        } else {
            XB_SPIN(xb_ld(&bar[XB_XGEN(x)]) == gen, bar);
            __builtin_amdgcn_fence(__ATOMIC_ACQUIRE, "agent");
            asm volatile("s_waitcnt vmcnt(0)" ::: "memory");
        }
    }
    __syncthreads();
}
#define PH_T0() unsigned long long ph_t0_ = 0; if (AMP_MASK) ph_t0_ = __builtin_amdgcn_s_memrealtime()
#define PH_AMP(i) do { if (AMP_MASK & (1u << (i))) { const unsigned long long t1_ = __builtin_amdgcn_s_memrealtime(); while (__builtin_amdgcn_s_memrealtime() - t1_ < t1_ - ph_t0_) __builtin_amdgcn_s_sleep(8); } } while (0)
__device__ __forceinline__ void transpose_item(const float* W, int K, int N, bf16_t* WT, int mode, float* scr, int item, int lane) {
    const int nblk = N / 32, kb = item / nblk, nb = item % nblk, k0 = 64 * kb, n0 = 32 * nb;
    int drow0 = mode == 0 ? n0 : (256 * (n0 >> 7) + (n0 & 127) + (mode == 2 ? 128 : 0));
    if (mode == 3) {
        const int seg = n0 >> 8, c = n0 & 255, pr = 256 * (c >> 7) + (c & 127);
        drow0 = seg == 0 ? pr : seg == 1 ? 512 + c : seg == 2 ? pr + 128 : seg == 3 ? 768 + c : seg == 4 ? 1024 + pr : seg == 5 ? 1024 + pr + 128 : n0;
    }
    float wv_[32];
#pragma unroll
    for (int i = 0; i < 32; ++i) wv_[i] = W[(size_t)(k0 + 2 * i + (lane >> 5)) * N + n0 + (lane & 31)];
#pragma unroll
    for (int i = 0; i < 32; ++i) scr[(2 * i + (lane >> 5)) * 33 + (lane & 31)] = wv_[i];
    asm volatile("s_waitcnt lgkmcnt(0)" ::: "memory");
    const int c = lane & 7;
#pragma unroll
    for (int j = 0; j < 4; ++j) { const int n = (lane >> 3) + 8 * j; const float* s = scr + (8 * c) * 33 + n;
        u32x4 o; o.x = cvt_pk_bf16(s[0 * 33], s[1 * 33]); o.y = cvt_pk_bf16(s[2 * 33], s[3 * 33]); o.z = cvt_pk_bf16(s[4 * 33], s[5 * 33]); o.w = cvt_pk_bf16(s[6 * 33], s[7 * 33]);
        *(u32x4*)(WT + (size_t)(drow0 + n) * K + k0 + 8 * c) = o; }
    asm volatile("s_waitcnt lgkmcnt(0)" ::: "memory");
}

__device__ __forceinline__ void fused_pool_item(const float* W, const float* poolw, const float* scale, bf16_t* WT, float* scr, int item, int lane) {
    const int K = DM, N = DM, nblk = N / 32, kb = item / nblk, nb = item % nblk, k0 = 64 * kb, n0 = 32 * nb;
    const int n = lane & 31, half = lane >> 5;
    float a[32];
#pragma unroll
    for (int i = 0; i < 32; ++i) a[i] = 0.f;
    for (int d = 0; d < 64; ++d) {
        const float wv = W[(size_t)(k0 + d) * N + n0 + n] * scale[d];
#pragma unroll
        for (int i = 0; i < 32; ++i) a[i] += poolw[(2 * i + half) * 64 + d] * wv;
    }
#pragma unroll
    for (int i = 0; i < 32; ++i) scr[(2 * i + half) * 33 + n] = a[i];
    asm volatile("s_waitcnt lgkmcnt(0)" ::: "memory");
    const int c = lane & 7;
#pragma unroll
    for (int j = 0; j < 4; ++j) { const int nn = (lane >> 3) + 8 * j; const float* s = scr + (8 * c) * 33 + nn;
        u32x4 o; o.x = cvt_pk_bf16(s[0 * 33], s[1 * 33]); o.y = cvt_pk_bf16(s[2 * 33], s[3 * 33]); o.z = cvt_pk_bf16(s[4 * 33], s[5 * 33]); o.w = cvt_pk_bf16(s[6 * 33], s[7 * 33]);
        *(u32x4*)(WT + (size_t)(n0 + nn) * K + k0 + 8 * c) = o; }
    asm volatile("s_waitcnt lgkmcnt(0)" ::: "memory");
}

__device__ __forceinline__ void unpack8(const u32x4 w, float (&f)[8]) {
    f[0] = __uint_as_float(w.x << 16); f[1] = __uint_as_float(w.x & 0xffff0000u); f[2] = __uint_as_float(w.y << 16); f[3] = __uint_as_float(w.y & 0xffff0000u);
    f[4] = __uint_as_float(w.z << 16); f[5] = __uint_as_float(w.z & 0xffff0000u); f[6] = __uint_as_float(w.w << 16); f[7] = __uint_as_float(w.w & 0xffff0000u);
}
struct MixRaw { u32x4 ra[2][4], rb[3], rc[4]; };
__device__ __forceinline__ void mix_load(MixRaw& R, int item, const bf16_t* zm, int tq, int ch) {
    const int b = item >> 8, s0 = (item & 255) * 32; const size_t row0 = (size_t)b * SEQ + s0;
    const u32x4 zero4 = (u32x4){0u, 0u, 0u, 0u};
#pragma unroll
    for (int it = 0; it < 2; ++it) { const int tk = tq + 16 * it, s = s0 + tk; const size_t row = row0 + tk;
        R.ra[it][0] = *(const u32x4*)(zm + row * ZW + 256 + ch);
#pragma unroll
        for (int k = 0; k < 3; ++k) R.ra[it][1 + k] = (s - 2 + k >= 0) ? *(const u32x4*)(zm + (row - 2 + k) * ZW + ch) : zero4; }
#pragma unroll
    for (int it = 0; it < 3; ++it) { const int j = tq + 16 * it; R.rb[it] = (s0 - 16 + j >= 0) ? *(const u32x4*)(zm + (row0 + j - 16) * ZW + 512 + ch) : zero4; }
#pragma unroll
    for (int it = 0; it < 4; ++it) { const int j = tq + 16 * it; R.rc[it] = (j < 62 && s0 - 30 + j >= 0) ? *(const u32x4*)(zm + (row0 + j - 30) * ZW + 768 + ch) : zero4; }
}
__device__ __forceinline__ void mixers_run(int it0, int it1, const bf16_t* zm, bf16_t* ymix, const float* scw,
                                           const float* dww, const float* dwb, const float* clg, const float* clb, unsigned char* smem, int wv) {
    const int lane = fresh_lane(), tid = wv * 64 + lane;
    const int ch = (tid & 31) * 8, tq = tid >> 5;
    const int c = tid & 255, th = tid >> 8;
    float* P = (float*)smem;
    float* H = (float*)(smem + 49152);
    float* O = (float*)(smem + 112640);
    f32x4 wa0[3], wa1[3]; float w[31];
#pragma unroll
    for (int k = 0; k < 3; ++k) { wa0[k] = *(const f32x4*)(scw + k * 256 + ch); wa1[k] = *(const f32x4*)(scw + k * 256 + ch + 4); }
#pragma unroll
    for (int k = 0; k < 31; ++k) w[k] = dww[k * 256 + c];
    const float bias = dwb[c];
    const f32x4 gq = *(const f32x4*)(clg + 4 * lane), bq = *(const f32x4*)(clb + 4 * lane);
    MixRaw R;
    if (it0 < it1) mix_load(R, it0, zm, tq, ch);
    for (int item = it0; item < it1; ++item) {
        const int b = item >> 8, s0 = (item & 255) * 32; const size_t row0 = (size_t)b * SEQ + s0;
#pragma unroll
        for (int it = 0; it < 3; ++it) { const int j = tq + 16 * it; float v[8]; unpack8(R.rb[it], v);
            *(f32x4*)(P + j * 256 + ch) = (f32x4){v[0], v[1], v[2], v[3]}; *(f32x4*)(P + j * 256 + ch + 4) = (f32x4){v[4], v[5], v[6], v[7]}; }
#pragma unroll
        for (int it = 0; it < 4; ++it) { const int j = tq + 16 * it; if (j < 62) { float v[8]; unpack8(R.rc[it], v);
            *(f32x4*)(H + j * 256 + ch) = (f32x4){v[0], v[1], v[2], v[3]}; *(f32x4*)(H + j * 256 + ch + 4) = (f32x4){v[4], v[5], v[6], v[7]}; } }
        __syncthreads();
#pragma unroll
        for (int it = 0; it < 2; ++it) {
            float zb[8], a[8]; unpack8(R.ra[it][0], zb);
#pragma unroll
            for (int j = 0; j < 8; ++j) a[j] = 0.f;
#pragma unroll
            for (int k = 0; k < 3; ++k) { float pz[8]; unpack8(R.ra[it][1 + k], pz);
                a[0] += wa0[k][0] * pz[0]; a[1] += wa0[k][1] * pz[1]; a[2] += wa0[k][2] * pz[2]; a[3] += wa0[k][3] * pz[3];
                a[4] += wa1[k][0] * pz[4]; a[5] += wa1[k][1] * pz[5]; a[6] += wa1[k][2] * pz[6]; a[7] += wa1[k][3] * pz[7]; }
#pragma unroll
            for (int j = 0; j < 8; ++j) a[j] *= zb[j];
            st8(ymix + (row0 + tq + 16 * it) * DM + ch, a);
        }
        if (item + 1 < it1) mix_load(R, item + 1, zm, tq, ch);
#pragma unroll
        for (int it = 0; it < 2; ++it) {
            const int t = tq + 16 * it, s = s0 + t; const int ww = 2 << (ch >> 6); const int cntv = (s + 1 < ww) ? (s + 1) : ww;
            f32x4 a0 = (f32x4){0.f, 0.f, 0.f, 0.f}, a1 = a0;
            for (int j = 0; j < ww; ++j) { a0 += *(const f32x4*)(P + (16 + t - j) * 256 + ch); a1 += *(const f32x4*)(P + (16 + t - j) * 256 + ch + 4); }
            const float inv = 1.0f / (float)cntv;
            const f32x4 z0 = *(const f32x4*)(P + (16 + t) * 256 + ch), z1 = *(const f32x4*)(P + (16 + t) * 256 + ch + 4);
            a0 = a0 * inv - z0; a1 = a1 * inv - z1;
            float o[8] = {a0[0], a0[1], a0[2], a0[3], a1[0], a1[1], a1[2], a1[3]};
            st8(ymix + (row0 + t) * DM + 256 + ch, o);
        }
        {
            float win[46];
#pragma unroll
            for (int q = 0; q < 46; ++q) win[q] = H[(th * 16 + q) * 256 + c];
#pragma unroll
            for (int j = 0; j < 16; ++j) { float o = bias;
#pragma unroll
                for (int k = 0; k < 31; ++k) o += w[k] * win[j + k];
                O[(th * 16 + j) * 256 + c] = o; }
        }
        __syncthreads();
#pragma unroll
        for (int q = 0; q < 4; ++q) {
            const int t = wv * 4 + q; const f32x4 v = *(const f32x4*)(O + t * 256 + 4 * lane);
            const float mean = wave_sum((v[0] + v[1]) + (v[2] + v[3]), lane) * (1.0f / 256.0f);
            const f32x4 d = v - mean;
            const float var = wave_sum((d[0] * d[0] + d[1] * d[1]) + (d[2] * d[2] + d[3] * d[3]), lane) * (1.0f / 256.0f);
            const float rstd = 1.0f / sqrtf(var + LN_EPS);
            const f32x4 y = d * rstd * gq + bq;
            u32x2 o; o.x = cvt_pk_bf16(siluf_(y[0]), siluf_(y[1])); o.y = cvt_pk_bf16(siluf_(y[2]), siluf_(y[3]));
            *(u32x2*)(ymix + (row0 + t) * DM + 512 + 4 * lane) = o;
        }
        __syncthreads();
    }
}

__global__ void __launch_bounds__(NTHREADS, 2) trunk_fwd(Args args) {
    extern __shared__ __attribute__((aligned(16))) unsigned char smem[];
    cg::grid_group grid = cg::this_grid();
    LAS unsigned char* lds = (LAS unsigned char*)smem;
    const int tid = threadIdx.x, lane = tid & 63, wave = __builtin_amdgcn_readfirstlane(tid >> 6);
    const int bid = blockIdx.x, G = gridDim.x;
    const int gtid = bid * NTHREADS + tid, GT = G * NTHREADS;

    if (tid < 4) ((unsigned*)(smem + XB_LDS_OFF))[tid] = 0u;
    if (tid == 0) (void)xb_add((unsigned*)(args.ws + WS_CTL) + CW_XB + XB_XCNT(xb_xcc_id()), 1u);
    __syncthreads();
    PH_T0();
    {
        PH_PTRS0
        float* scr = (float*)(smem + wave * 16384);
        const int gw = bid * 8 + wave, NGW = G * 8;
        constexpr int I_IN = 16 * 56, I_O = 16 * 32, I_G = 16 * 88, I_D = 44 * 32, I_GLU = 4 * 8, I_L = I_IN + I_O + 2 * I_G + I_D + I_GLU;
        for (int it = gw; it < DEPTH * I_L; it += NGW) {
            const int l = it / I_L; int r = it % I_L;
            if (r < I_IN) { transpose_item(ka->in[4] + (size_t)l * DM * INW, DM, INW, win_t + (size_t)l * INW * DM, 3, scr, r, lane); continue; } r -= I_IN;
            if (r < I_O) {
                const int kb = r / 32;
                if (kb >= 4 && kb < 8) fused_pool_item(ka->in[23] + (size_t)l * DM * DM, ka->in[7] + (size_t)l * 16384 + (kb - 4) * 4096, ka->in[8] + l * 256 + (kb - 4) * 64, wo_t + (size_t)l * DM * DM, scr, r, lane);
                else transpose_item(ka->in[23] + (size_t)l * DM * DM, DM, DM, wo_t + (size_t)l * DM * DM, 0, scr, r, lane);
                continue; } r -= I_O;
            if (r < I_G) { transpose_item(ka->in[26] + (size_t)l * DM * FF, DM, FF, wgu_t + (size_t)l * 2 * FF * DM, 1, scr, r, lane); continue; } r -= I_G;
            if (r < I_G) { transpose_item(ka->in[27] + (size_t)l * DM * FF, DM, FF, wgu_t + (size_t)l * 2 * FF * DM, 2, scr, r, lane); continue; } r -= I_G;
            if (r < I_D) { transpose_item(ka->in[28] + (size_t)l * FF * DM, FF, DM, wdn_t + (size_t)l * DM * FF, 0, scr, r, lane); continue; } r -= I_D;
            transpose_item(ka->in[21] + (size_t)l * 65536, 256, 256, wglu_t + (size_t)l * 65536, 0, scr, r, lane);
        }
        __syncthreads();
        float* cond = (float*)smem; float* red = (float*)(smem + 32768);
        for (int i = tid; i < NB * DM; i += NTHREADS) { const float v = ka->in[1][i]; cond[i] = siluf_(v); }
        __syncthreads();
        for (int item = bid; item < DEPTH * 96; item += G) {
            const int l = item / 96, n = (item % 96) * 64 + lane;
            const float* Wp = ka->in[2] + (size_t)l * DM * 6144 + n;
            float a[8];
#pragma unroll
            for (int q = 0; q < 8; ++q) a[q] = 0.f;
            for (int k0 = wave * 128; k0 < wave * 128 + 128; k0 += 16) {
                float wv_[16];
#pragma unroll
                for (int j = 0; j < 16; ++j) wv_[j] = Wp[(size_t)(k0 + j) * 6144];
#pragma unroll
                for (int j = 0; j < 16; ++j)
#pragma unroll
                    for (int q = 0; q < 8; ++q) a[q] += cond[q * DM + k0 + j] * wv_[j];
            }
#pragma unroll
            for (int q = 0; q < 8; ++q) red[(wave * 8 + q) * 64 + lane] = a[q];
            __syncthreads();
            float s = 0.f;
#pragma unroll
            for (int w2 = 0; w2 < 8; ++w2) s += red[(w2 * 8 + wave) * 64 + lane];
            mod[(size_t)(l * 8 + wave) * 6144 + n] = s + ka->in[3][l * 6144 + n];
            __syncthreads();
        }
        if (gtid < DEPTH * 16 * 64) {
            const int idx = gtid, lg = idx >> 6;
            const float dt = __expf(ka->in[15][lg]), lr = ka->in[13][idx], li = ka->in[14][idx];
            const float a = lr * dt, tt = li * dt * 0.15915494309189535f;
            float lbr = 0.f, lbi = 0.f;
            for (int k = 0; k <= 32; ++k) {
                const float mag = __expf((float)k * a), tk = (float)k * tt, frc = tk - rintf(tk);
                const float cr = mag * __builtin_amdgcn_cosf(frc), ci = mag * __builtin_amdgcn_sinf(frc);
                pw[idx * 33 + k] = (f32x2){cr, ci};
                if (k == 1) { lbr = cr; lbi = ci; }
            }
            const float nr = lbr - 1.0f, ni = lbi, inv = 1.0f / (lr * lr + li * li);
            const float qr = (nr * lr + ni * li) * inv, qi = (ni * lr - nr * li) * inv;
            for (int h = 0; h < 16; ++h) { const float br = ka->in[16][idx * 16 + h], bi = ka->in[17][idx * 16 + h];
                bbar[idx * 16 + h] = (f32x2){qr * br - qi * bi, qr * bi + qi * br}; }
        }
    }
    grid.sync();
    {
        PH_PTRS0
        for (int idx = gtid; idx < DEPTH * 16 * 32 * 256; idx += GT) {
            const int hp = idx & 15, h = (idx >> 4) & 15, k = (idx >> 8) & 31, lg = idx >> 13;
            const float* cre = ka->in[18] + (size_t)(lg * 16 + h) * 64; const float* cim = ka->in[19] + (size_t)(lg * 16 + h) * 64;
            float sum = 0.f;
            for (int p = 0; p < 64; ++p) { const f32x2 w = pw[(lg * 64 + p) * 33 + k], bb = bbar[(lg * 64 + p) * 16 + hp];
                const float tr = w.x * bb.x - w.y * bb.y, ti = w.x * bb.y + w.y * bb.x; sum += cre[p] * tr - cim[p] * ti; }
            Kk[idx] = sum;
        }
        for (int idx = gtid; idx < DEPTH * 16 * 256 * 32; idx += GT) {
            const int s = idx & 31, row = (idx >> 5) & 255, lg = idx >> 13;
            bf16_t* dst = w1m + ((size_t)(lg * 256 + row) * 512 + s * 16);
            float v[16];
            if (row < 128) { const int p = row >> 1, ri = row & 1; const f32x2 w = pw[(lg * 64 + p) * 33 + (31 - s)];
#pragma unroll
                for (int hp = 0; hp < 16; ++hp) { const f32x2 bb = bbar[(lg * 64 + p) * 16 + hp]; v[hp] = ri ? (w.x * bb.y + w.y * bb.x) : (w.x * bb.x - w.y * bb.y); } }
            else {
#pragma unroll
                for (int hp = 0; hp < 16; ++hp) v[hp] = 0.f;
            }
            u32x4 o0, o1; o0.x = cvt_pk_bf16(v[0], v[1]); o0.y = cvt_pk_bf16(v[2], v[3]); o0.z = cvt_pk_bf16(v[4], v[5]); o0.w = cvt_pk_bf16(v[6], v[7]);
            o1.x = cvt_pk_bf16(v[8], v[9]); o1.y = cvt_pk_bf16(v[10], v[11]); o1.z = cvt_pk_bf16(v[12], v[13]); o1.w = cvt_pk_bf16(v[14], v[15]);
            *(u32x4*)dst = o0; *(u32x4*)(dst + 8) = o1;
        }
        for (int idx = gtid; idx < DEPTH * 16 * 32 * 16 * 8; idx += GT) {
            const int pc = idx & 7, h = (idx >> 3) & 15, t = (idx >> 7) & 31, lg = idx >> 12;
            bf16_t* dst = btout + ((size_t)(lg * 512 + t * 16 + h) * KSSM + 512 + pc * 16);
            const float* cre = ka->in[18] + (size_t)(lg * 16 + h) * 64 + pc * 8; const float* cim = ka->in[19] + (size_t)(lg * 16 + h) * 64 + pc * 8;
            float v[16];
#pragma unroll
            for (int j = 0; j < 8; ++j) { const f32x2 w = pw[(lg * 64 + pc * 8 + j) * 33 + t + 1]; const float cr = cre[j], ci = cim[j];
                v[2 * j] = cr * w.x - ci * w.y; v[2 * j + 1] = -(cr * w.y + ci * w.x); }
            u32x4 o0, o1; o0.x = cvt_pk_bf16(v[0], v[1]); o0.y = cvt_pk_bf16(v[2], v[3]); o0.z = cvt_pk_bf16(v[4], v[5]); o0.w = cvt_pk_bf16(v[6], v[7]);
            o1.x = cvt_pk_bf16(v[8], v[9]); o1.y = cvt_pk_bf16(v[10], v[11]); o1.z = cvt_pk_bf16(v[12], v[13]); o1.w = cvt_pk_bf16(v[14], v[15]);
            *(u32x4*)dst = o0; *(u32x4*)(dst + 8) = o1;
        }
        for (size_t idx0 = gtid; idx0 < (size_t)MTOK * DM / 8; idx0 += (size_t)4 * GT) {
            f32x4 xa[4], xb[4];
#pragma unroll
            for (int uu = 0; uu < 4; ++uu) { const size_t e = (idx0 + (size_t)uu * GT) * 8; xa[uu] = *(const f32x4*)(ka->in[0] + e); xb[uu] = *(const f32x4*)(ka->in[0] + e + 4); }
#pragma unroll
            for (int uu = 0; uu < 4; ++uu) {
                const size_t e = (idx0 + (size_t)uu * GT) * 8; const int col = (int)(e & (DM - 1)); const int b = (int)(e >> 23);
                const float* mb = mod + (size_t)b * 6144;
                const f32x4 sh0 = *(const f32x4*)(mb + col), sh1 = *(const f32x4*)(mb + col + 4), sc0 = *(const f32x4*)(mb + 1024 + col), sc1 = *(const f32x4*)(mb + 1024 + col + 4);
                const f32x4 h0 = xa[uu] * (sc0 + 1.0f) + sh0, h1 = xb[uu] * (sc1 + 1.0f) + sh1;
                u32x4 w; w.x = cvt_pk_bf16(h0[0], h0[1]); w.y = cvt_pk_bf16(h0[2], h0[3]); w.z = cvt_pk_bf16(h1[0], h1[1]); w.w = cvt_pk_bf16(h1[2], h1[3]);
                *(u32x4*)(hmod + e) = w;
            }
        }
    }
    grid_bar(wave, smem);
    { PH_PTRS0
    for (int idx = gtid; idx < DEPTH * 16 * 32 * 16 * 32; idx += GT) {
        const int s = idx & 31, h = (idx >> 5) & 15, t = (idx >> 9) & 31, lg = idx >> 14;
        bf16_t* dst = btout + ((size_t)(lg * 512 + t * 16 + h) * KSSM + s * 16);
        float v[16];
        if (s <= t) { const float* kp = Kk + ((size_t)(lg * 32 + (t - s)) * 16 + h) * 16; const float dd = (s == t) ? ka->in[20][lg * 16 + h] : 0.f;
#pragma unroll
            for (int hp = 0; hp < 16; ++hp) v[hp] = kp[hp] + (hp == h ? dd : 0.f); }
        else {
#pragma unroll
            for (int hp = 0; hp < 16; ++hp) v[hp] = 0.f;
        }
        u32x4 o0, o1; o0.x = cvt_pk_bf16(v[0], v[1]); o0.y = cvt_pk_bf16(v[2], v[3]); o0.z = cvt_pk_bf16(v[4], v[5]); o0.w = cvt_pk_bf16(v[6], v[7]);
        o1.x = cvt_pk_bf16(v[8], v[9]); o1.y = cvt_pk_bf16(v[10], v[11]); o1.z = cvt_pk_bf16(v[12], v[13]); o1.w = cvt_pk_bf16(v[14], v[15]);
        *(u32x4*)dst = o0; *(u32x4*)(dst + 8) = o1;
    }
    }
    PH_AMP(0);
    grid_bar(wave, smem);

    for (int l = 0; l < DEPTH; ++l) {
        for (int rep = 0; rep < REP_MIX; ++rep) {
        { PH_T0();
        {
            PH_PTRS
            pg8::Gemm g{hmod, win_t + (size_t)l * INW * DM, DM, DM, DM};
            pg8::StaticOrder S; S.init(MTOK, INW, G, bid);
            pg8::EpiZ E{zmain, apr, ka->in[5] + l * INW};
            pg8::gemm_phase<pg8::EpiZ, pg8::StaticOrder, true>(lds, g, S, E, wave);
        }
        PH_AMP(1); }
        grid_bar(wave, smem);
        { PH_T0();
        {
            PH_PTRS
            int bidl = bid; asm volatile("" : "+s"(bidl));
            if (bidl < 128) {
                const int gq = bidl >> 3;
                {
                    pg8::Gemm g{apr, w1m + (size_t)l * 4096 * 512, 512, KSSM, 512};
                    pg8::OneUnit S{bidl, gq, true};
                    pg8::EpiStates E{Sst};
                    pg8::gemm_phase<pg8::EpiStates, pg8::OneUnit, true>(lds, g, S, E, wave);
                }
                asm volatile("s_waitcnt vmcnt(0)" ::: "memory");
                __syncthreads();
                {
                    int wvl = wave; asm volatile("" : "+s"(wvl));
                    const int ln = fresh_lane(); const int rowbase = bidl * NCH + wvl * 32;
                    const f32x2 mult = pw[((l * 16 + gq) * 64 + ln) * 33 + 32];
                    f32x2 sv[32];
#pragma unroll
                    for (int j = 0; j < 32; ++j) sv[j] = *(const f32x2*)(Sst + (size_t)(rowbase + j) * 128 + 2 * ln);
                    float er = 0.f, ei = 0.f;
#pragma unroll
                    for (int j = 0; j < 32; ++j) { const float nr = mult.x * er - mult.y * ei + sv[j].x, ni = mult.x * ei + mult.y * er + sv[j].y; er = nr; ei = ni; }
                    f32x2* ex = (f32x2*)(smem + 131072);
                    ex[wvl * 64 + ln] = (f32x2){er, ei};
                    float mr = mult.x, mi = mult.y;
#pragma unroll
                    for (int q = 0; q < 5; ++q) { const float nr = mr * mr - mi * mi, ni = 2.0f * mr * mi; mr = nr; mi = ni; }
                    __syncthreads();
                    float xr = 0.f, xi = 0.f;
                    for (int w2 = 0; w2 < wvl; ++w2) { const f32x2 e = ex[w2 * 64 + ln]; const float nr = mr * xr - mi * xi + e.x, ni = mr * xi + mi * xr + e.y; xr = nr; xi = ni; }
#pragma unroll
                    for (int j = 0; j < 32; ++j) {
                        *(unsigned*)(apr + (size_t)(rowbase + j) * KSSM + 512 + 2 * ln) = cvt_pk_bf16(xr, xi);
                        const float nr = mult.x * xr - mult.y * xi + sv[j].x, ni = mult.x * xi + mult.y * xr + sv[j].y; xr = nr; xi = ni;
                    }
                }
                asm volatile("s_waitcnt vmcnt(0)" ::: "memory");
                __syncthreads();
                {
                    pg8::Gemm g{apr, btout + (size_t)l * 8192 * KSSM, KSSM, KSSM, KSSM};
                    pg8::PairOrder S{bidl, gq * 2};
                    pg8::EpiSsmOut E{yg};
                    pg8::gemm_phase<pg8::EpiSsmOut, pg8::PairOrder, true>(lds, g, S, E, wave);
                }
                __syncthreads();
            }
            const int it0 = bidl < 128 ? bidl * 5 : 640 + (bidl - 128) * 11, it1 = it0 + (bidl < 128 ? 5 : 11);
            mixers_run(it0, it1, zmain, ymix, ka->in[6] + l * 768, ka->in[9] + l * 7936,
                       ka->in[10] + l * 256, ka->in[11] + l * 256, ka->in[12] + l * 256, smem, wave);
        }
        PH_AMP(2); }
        grid_bar(wave, smem);
        { PH_T0();
        {
            PH_PTRS
            pg8::Gemm g{yg, wglu_t + (size_t)l * 65536, 256, 256, 256};
            pg8::StaticOrder S; S.init(MTOK, 256, G, bid);
            pg8::EpiGlu E{yg, ymix, ka->in[22] + l * 256};
            pg8::gemm_phase<pg8::EpiGlu, pg8::StaticOrder, true>(lds, g, S, E, wave);
        }
        PH_AMP(4); }
        grid_bar(wave, smem);
        }
        { PH_T0();
        {
            PH_PTRS
            pg8::Gemm g{ymix, wo_t + (size_t)l * DM * DM, DM, DM, DM};
            pg8::RoundOrder S{bid & 7, bid >> 3};
            pg8::EpiLn E{(float*)nullptr, hmod, modl + 2048, modl + 1024, modl, ka->in[24] + l * DM, ka->in[25] + l * DM, modl + 4096, modl + 3072,
                         (unsigned long long*)(ws + WS_XCH), ctl + CW_TMO, (unsigned)(2 * l) & 7u, lds + 131072};
            pg8::gemm_phase<pg8::EpiLn, pg8::RoundOrder, true>(lds, g, S, E, wave);
        }
        PH_AMP(5); }
        grid_bar(wave, smem);
        { PH_T0();
        for (int rep = 0; rep < REP_P6; ++rep) {
            PH_PTRS
            pg8::Gemm g{hmod, wgu_t + (size_t)l * 2 * FF * DM, DM, DM, DM};
            pg8::StaticOrder S; S.init(MTOK, 2 * FF, G, bid);
            pg8::EpiSwiGlu E{hid};
            pg8::gemm_phase<pg8::EpiSwiGlu, pg8::StaticOrder, true>(lds, g, S, E, wave);
        }
        PH_AMP(6); }
        grid_bar(wave, smem);
        { PH_T0();
        {
            PH_PTRS
            const float* modn = mod + (size_t)(l + 1 < DEPTH ? l + 1 : l) * 8 * 6144;
            pg8::Gemm g{hid, wdn_t + (size_t)l * DM * FF, FF, FF, FF};
            pg8::RoundOrder S{bid & 7, bid >> 3};
            pg8::EpiLn E{(l + 1 < DEPTH) ? (float*)nullptr : xres, hmod, modl + 5120, modl + 4096, modl + 3072, ka->in[29] + l * DM, ka->in[30] + l * DM, modn + 1024, modn,
                         (unsigned long long*)(ws + WS_XCH), ctl + CW_TMO, (unsigned)(2 * l + 1) & 7u, lds + 131072};
            pg8::gemm_phase<pg8::EpiLn, pg8::RoundOrder, true>(lds, g, S, E, wave);
        }
        PH_AMP(7); }
        grid_bar(wave, smem);
    }
}

extern "C" void kernel_launch(void* const* d_in, const int* in_sizes, int n_in, void* d_out, int out_size, void* d_ws, size_t ws_size, hipStream_t stream) {
    static int ready = 0;
    if (ready == 0) {
        ready = 1;
        if (n_in != 31 || out_size != MTOK * DM || ws_size < WS_END) { fprintf(stderr, "kernel_launch: unexpected shapes (n_in %d, out %d, ws %zu)\n", n_in, out_size, ws_size); ready = -1; }
        else if (hipFuncSetAttribute((const void*)trunk_fwd, hipFuncAttributeMaxDynamicSharedMemorySize, LDS_BYTES) != hipSuccess) { fprintf(stderr, "kernel_launch: hipFuncSetAttribute failed\n"); ready = -1; }
        else { int per_cu = 0; if (hipOccupancyMaxActiveBlocksPerMultiprocessor(&per_cu, (const void*)trunk_fwd, NTHREADS, LDS_BYTES) != hipSuccess || per_cu < 1) fprintf(stderr, "kernel_launch: occupancy query reports %d\n", per_cu); (void)hipGetLastError(); }
    }
    if (ready < 0) return;
    (void)hipMemsetAsync((char*)d_ws + WS_CTL, 0, CTL_BYTES, stream);
    Args a{};
    for (int i = 0; i < 31; ++i) a.in[i] = (const float*)d_in[i];
    a.out = (float*)d_out; a.ws = (unsigned char*)d_ws;
    void* kargs[] = {&a};
    hipError_t e = hipLaunchCooperativeKernel((const void*)trunk_fwd, dim3(GRID), dim3(NTHREADS), kargs, LDS_BYTES, stream);
    if (e != hipSuccess) fprintf(stderr, "kernel_launch: cooperative launch failed: %s\n", hipGetErrorString(e));
}
```

```cpp
#include <hip/hip_runtime.h>
#include <hip/hip_cooperative_groups.h>
#include <cstdio>
#include <cstdint>
namespace cg = cooperative_groups;

#define LAS __attribute__((address_space(3)))
typedef unsigned short bf16_t;
typedef short bf16x8 __attribute__((ext_vector_type(8)));
typedef float f32x4 __attribute__((ext_vector_type(4)));
typedef float f32x2 __attribute__((ext_vector_type(2)));
typedef unsigned u32x4 __attribute__((ext_vector_type(4)));
typedef unsigned u32x2 __attribute__((ext_vector_type(2)));

constexpr int DM = 1024, NB = 8, SEQ = 8192, MTOK = NB * SEQ, DEPTH = 4, FF = 2816, INW = 1792, ZW = 1024;
constexpr int CT = 32, NCH = SEQ / CT, NBC = NB * NCH, KSSM = 640;
constexpr float ALPHA = 1.681792830507429f;
constexpr float LN_EPS = 1e-5f;
constexpr int NTHREADS = 512, GRID = 256;
constexpr unsigned AMP_MASK = 0u;
constexpr int REP_MIX = 1, REP_P6 = 1;

constexpr size_t MiB = 1u << 20;
constexpr size_t WS_CTL = 0, CTL_BYTES = 1 * MiB;
constexpr size_t WS_XCH = 1 * MiB;
constexpr size_t WS_MOD = 3 * MiB;
constexpr size_t WS_PW = 4 * MiB;
constexpr size_t WS_BBAR = 6 * MiB;
constexpr size_t WS_KK = 7 * MiB;
constexpr size_t WS_WIN = 10 * MiB;
constexpr size_t WS_WO = 24 * MiB;
constexpr size_t WS_WGU = 32 * MiB;
constexpr size_t WS_WDN = 76 * MiB;
constexpr size_t WS_WGLU = 98 * MiB;
constexpr size_t WS_BTOUT = 100 * MiB;
constexpr size_t WS_W1 = 140 * MiB;
constexpr size_t WS_HMOD = 156 * MiB;
constexpr size_t WS_ZMAIN = 284 * MiB;
constexpr size_t WS_APR = 476 * MiB;
constexpr size_t WS_S = 516 * MiB;
constexpr size_t WS_YG = 532 * MiB;
constexpr size_t WS_YMIX = 564 * MiB;
constexpr size_t WS_HID = 284 * MiB;
constexpr size_t WS_LNT = 692 * MiB;
constexpr size_t WS_END = 694 * MiB;
constexpr int CW_TMO = 0, CW_CNT = 1024, CW_XB = 32768;

constexpr int LDS_BYTES = 147456;

__device__ __forceinline__ unsigned cvt_pk_bf16(float lo, float hi) { unsigned r; asm volatile("v_cvt_pk_bf16_f32 %0, %1, %2" : "=v"(r) : "v"(lo), "v"(hi)); return r; }
__device__ __forceinline__ void ld8(const bf16_t* p, float (&f)[8]) {
    const u32x4 w = *(const u32x4*)p;
    f[0] = __uint_as_float(w.x << 16); f[1] = __uint_as_float(w.x & 0xffff0000u);
    f[2] = __uint_as_float(w.y << 16); f[3] = __uint_as_float(w.y & 0xffff0000u);
    f[4] = __uint_as_float(w.z << 16); f[5] = __uint_as_float(w.z & 0xffff0000u);
    f[6] = __uint_as_float(w.w << 16); f[7] = __uint_as_float(w.w & 0xffff0000u);
}
__device__ __forceinline__ void st8(bf16_t* p, const float (&f)[8]) {
    u32x4 w; w.x = cvt_pk_bf16(f[0], f[1]); w.y = cvt_pk_bf16(f[2], f[3]); w.z = cvt_pk_bf16(f[4], f[5]); w.w = cvt_pk_bf16(f[6], f[7]);
    *(u32x4*)p = w;
}
__device__ __forceinline__ float sigmoidf_(float a) { return __builtin_amdgcn_rcpf(1.0f + __expf(-a)); }
__device__ __forceinline__ float siluf_(float a) { return a * sigmoidf_(a); }
__device__ __forceinline__ float gelu_tanh_(float v) { const float u = 0.7978845608028654f * (v + 0.044715f * v * v * v); return v * sigmoidf_(2.0f * u); }
__device__ __forceinline__ int fresh_lane() { int l; asm volatile("v_mbcnt_lo_u32_b32 %0, -1, 0\n\tv_mbcnt_hi_u32_b32 %0, -1, %0" : "=v"(l)); return l; }
__device__ __forceinline__ float shfl_xor_l(float v, int o, int lane) { return __int_as_float(__builtin_amdgcn_ds_bpermute((lane ^ o) << 2, __float_as_int(v))); }
__device__ __forceinline__ float sum_x16_x32(float v) {
    const auto r = __builtin_amdgcn_permlane16_swap(__float_as_uint(v), __float_as_uint(v), false, false);
    const float y = __uint_as_float(r[0]) + __uint_as_float(r[1]);
    const auto r2 = __builtin_amdgcn_permlane32_swap(__float_as_uint(y), __float_as_uint(y), false, false);
    return __uint_as_float(r2[0]) + __uint_as_float(r2[1]);
}
__device__ __forceinline__ float wave_sum(float v, int lane) {
#pragma unroll
    for (int o = 1; o < 64; o <<= 1) v += shfl_xor_l(v, o, lane);
    return v;
}

namespace pg8 {
constexpr int BM = 256, BK = 64, HALF = 128, HTB = HALF * BK * 2, STAGE_BYTES = 8 * HTB, NXCD = 8, WGM = 4;
__host__ __device__ __forceinline__ int lds_byte(int r, int c) { const int st = (r >> 4) * 2 + (c >> 5), rr = r & 15, cc = c & 31, ob = rr * 64 + cc * 2; return st * 1024 + (ob ^ (((ob >> 9) & 1) << 5)); }
__host__ __device__ __forceinline__ void stage_rc(int b, int& R, int& C) { const int st = b / 1024, sb = b % 1024, swz = sb ^ (((sb >> 9) & 1) << 5); R = (st >> 1) * 16 + swz / 64; C = (st & 1) * 32 + (swz % 64) / 2; }
__host__ __device__ __forceinline__ int perm32(int rho) { const int n = rho >> 4, i = rho & 15; return 8 * (i >> 2) + 4 * n + (i & 3); }

struct Unit { int pm, pn; };
struct Gemm { const bf16_t* A; const bf16_t* Bt; int K, lda, ldb; };

struct StaticOrder {
    int nM, nN, nwg, G, c;
    __device__ void init(int M, int N, int G_, int c_) { nM = M / BM; nN = N / BM; nwg = nM * nN; G = G_; c = c_; }
    __device__ bool next(int i, Unit& u) const {
        const long L = (long)i * G + c; if (L >= nwg) return false;
        int wgid = (int)L; { const int q = nwg / NXCD, r = nwg % NXCD, xcd = wgid % NXCD, off = wgid / NXCD; wgid = (xcd < r ? xcd * (q + 1) : r * (q + 1) + (xcd - r) * q) + off; }
        const int nig = WGM * nN, gid = wgid / nig, fm = gid * WGM;
        u.pm = fm + ((wgid % nig) % WGM); u.pn = (wgid % nig) / WGM; return true;
    }
};
struct RoundOrder {
    int xcd, slot;
    __device__ bool next(int i, Unit& u) const { if (i >= 4) return false; u.pm = i * 64 + xcd * 8 + (slot >> 2); u.pn = slot & 3; return true; }
};
struct PairOrder {
    int pm, pn0;
    __device__ bool next(int i, Unit& u) const { if (i >= 2) return false; u.pm = pm; u.pn = pn0 + i; return true; }
};
struct OneUnit {
    int pm, pn; bool valid;
    __device__ bool next(int i, Unit& u) const { if (i != 0 || !valid) return false; u.pm = pm; u.pn = pn; return true; }
};

template <class Epi, class Sched, bool ALIGN_EPI>
__device__ __forceinline__ void gemm_phase(LAS unsigned char* lds, const Gemm g, const Sched& S, const Epi& E, int wid) {
    asm volatile("" : "+s"(wid));
    const int wr = wid >> 2, wc = wid & 3; int fr = 0, fq = 0;
    const int K = g.K, nt = K / BK;
    unsigned voffA[2], voffB[2]; int aoff, boff;
#define PG8_LANE_CONSTS() do { const int lane_ = fresh_lane(), tid_ = wid * 64 + lane_; fr = lane_ & 15; fq = lane_ >> 4; \
        _Pragma("unroll") for (int i = 0; i < 2; ++i) { int R, C; stage_rc(tid_ * 16 + i * 8192, R, C); const int Rb = Epi::PERM ? ((R & ~31) + perm32(R & 31)) : R; \
            voffA[i] = (unsigned)(R * g.lda + C) * 2u; voffB[i] = (unsigned)(Rb * g.ldb + C) * 2u; } \
        aoff = lds_byte(wr * 64 + fr, fq * 8); boff = lds_byte(wc * 32 + fr, fq * 8); } while (0)
    PG8_LANE_CONSTS();
    const size_t kstep = (size_t)(BK * 2);
    const size_t hstepA = (size_t)HALF * g.lda * 2, hstepB = (size_t)HALF * g.ldb * 2;
    const size_t tstepA = 2 * hstepA, tstepB = 2 * hstepB;
    const unsigned ldsw = (unsigned)wid * 1024u;
#define PG8_SA(b, h) (((b) * 2 + (h)) * HTB)
#define PG8_SB(b, h) ((4 + (b) * 2 + (h)) * HTB)
#define PG8_STAGE(bufoff, gbase, voff) do { _Pragma("unroll") for (int _i = 0; _i < 2; ++_i) \
        __builtin_amdgcn_global_load_lds((const unsigned*)((const char*)(gbase) + (voff)[_i]), (LAS unsigned*)(lds + (bufoff) + ldsw + _i * 8192), 16, 0, 0); } while (0)
#define PG8_LDA(dst, b, h) do { _Pragma("unroll") for (int m = 0; m < 4; ++m) _Pragma("unroll") for (int k = 0; k < 2; ++k) dst[m][k] = *(const LAS bf16x8*)(lds + PG8_SA(b, h) + aoff + m * 2048 + k * 1024); } while (0)
#define PG8_LDB(dst, b, h) do { _Pragma("unroll") for (int n = 0; n < 2; ++n) _Pragma("unroll") for (int k = 0; k < 2; ++k) dst[n][k] = *(const LAS bf16x8*)(lds + PG8_SB(b, h) + boff + n * 2048 + k * 1024); } while (0)
#define PG8_MMA(ai, bj, At, Bt) do { __builtin_amdgcn_s_setprio(1); _Pragma("unroll") for (int m = 0; m < 4; ++m) _Pragma("unroll") for (int n = 0; n < 2; ++n) _Pragma("unroll") for (int k = 0; k < 2; ++k) \
        acc[ai][bj][m][n] = __builtin_amdgcn_mfma_f32_16x16x32_bf16(Bt[n][k], At[m][k], acc[ai][bj][m][n], 0, 0, 0); __builtin_amdgcn_s_setprio(0); } while (0)
#define PG8_WAIT_V(n) asm volatile("s_waitcnt vmcnt(" #n ")" ::: "memory")
#define PG8_WAIT_L(n) asm volatile("s_waitcnt lgkmcnt(" #n ")" ::: "memory")
#define PG8_BAR __builtin_amdgcn_s_barrier()
#define PG8_SCHED __builtin_amdgcn_sched_barrier(0)
    Unit cur, nxt; int ui = 0;
    if (!S.next(0, cur)) return;
    f32x4 acc[2][2][4][2];
#pragma unroll
    for (int a = 0; a < 2; ++a)
#pragma unroll
        for (int b = 0; b < 2; ++b)
#pragma unroll
            for (int m = 0; m < 4; ++m)
#pragma unroll
                for (int n = 0; n < 2; ++n) acc[a][b][m][n] = (f32x4){0.f, 0.f, 0.f, 0.f};
    bf16x8 At[4][2], B0[2][2], B1[2][2];
    const char* cA = (const char*)g.A + (size_t)cur.pm * tstepA; const char* cB = (const char*)g.Bt + (size_t)cur.pn * tstepB;
    PG8_STAGE(PG8_SB(0, 0), cB, voffB); PG8_STAGE(PG8_SB(0, 1), cB + hstepB, voffB); PG8_STAGE(PG8_SA(0, 0), cA, voffA); PG8_STAGE(PG8_SA(0, 1), cA + hstepA, voffA);
    if (wr == 1) PG8_BAR;
    PG8_WAIT_V(2); PG8_BAR;
    PG8_STAGE(PG8_SB(1, 0), cB + kstep, voffB); PG8_STAGE(PG8_SA(1, 0), cA + kstep, voffA); PG8_STAGE(PG8_SB(1, 1), cB + hstepB + kstep, voffB);
    PG8_WAIT_V(6); PG8_BAR;
    for (;;) {
        PG8_LANE_CONSTS();
        const bool has_next = S.next(ui + 1, nxt);
        const char* nA = has_next ? (const char*)g.A + (size_t)nxt.pm * tstepA : cA; const char* nB = has_next ? (const char*)g.Bt + (size_t)nxt.pn * tstepB : cB;
        for (int t = 0; t < nt; t += 2) {
            const bool last = (t == nt - 2);
            const char* a1 = cA + (size_t)(t + 1) * kstep;
            const char* a2 = last ? nA : cA + (size_t)(t + 2) * kstep; const char* b2 = last ? nB : cB + (size_t)(t + 2) * kstep;
            const char* a3 = a2 + kstep; const char* b3 = b2 + kstep;
            PG8_LDB(B0, 0, 0); PG8_LDB(B1, 0, 1); PG8_SCHED; PG8_LDA(At, 0, 0); PG8_STAGE(PG8_SA(1, 1), a1 + hstepA, voffA);
            PG8_WAIT_V(8); PG8_WAIT_L(0); PG8_BAR; PG8_MMA(0, 0, At, B0); PG8_MMA(0, 1, At, B1); PG8_BAR; PG8_SCHED;
            PG8_LDA(At, 0, 1); PG8_STAGE(PG8_SB(0, 0), b2, voffB); PG8_STAGE(PG8_SB(0, 1), b2 + hstepB, voffB); PG8_STAGE(PG8_SA(0, 0), a2, voffA);
            PG8_WAIT_V(8); PG8_WAIT_L(0); PG8_BAR; PG8_MMA(1, 0, At, B0); PG8_MMA(1, 1, At, B1); PG8_BAR; PG8_SCHED;
            PG8_LDB(B0, 1, 0); PG8_LDB(B1, 1, 1); PG8_SCHED; PG8_LDA(At, 1, 0); PG8_STAGE(PG8_SA(0, 1), a2 + hstepA, voffA);
            PG8_WAIT_V(8); PG8_WAIT_L(0); PG8_BAR; PG8_MMA(0, 0, At, B0); PG8_MMA(0, 1, At, B1); PG8_BAR; PG8_SCHED;
            PG8_LDA(At, 1, 1); PG8_STAGE(PG8_SB(1, 0), b3, voffB); PG8_STAGE(PG8_SB(1, 1), b3 + hstepB, voffB); PG8_STAGE(PG8_SA(1, 0), a3, voffA);
            PG8_WAIT_V(8); PG8_WAIT_L(0); PG8_BAR; PG8_MMA(1, 0, At, B0); PG8_MMA(1, 1, At, B1); PG8_BAR; PG8_SCHED;
        }
        if constexpr (ALIGN_EPI) { if (wr == 0) PG8_BAR; }
        if constexpr (!Epi::AFTER_DRAIN) { E(acc, cur, wr, wc, fr, fq); }
        if (!has_next) break;
#pragma unroll
        for (int a = 0; a < 2; ++a)
#pragma unroll
            for (int b = 0; b < 2; ++b)
#pragma unroll
                for (int m = 0; m < 4; ++m)
#pragma unroll
                    for (int n = 0; n < 2; ++n) acc[a][b][m][n] = (f32x4){0.f, 0.f, 0.f, 0.f};
        cur = nxt; cA = nA; cB = nB; ++ui;
        if constexpr (ALIGN_EPI) { if (wr == 1) PG8_BAR; }
    }
    PG8_WAIT_V(0);
    if constexpr (!ALIGN_EPI) { if (wr == 0) PG8_BAR; }
    PG8_BAR;
    static_assert(!Epi::AFTER_DRAIN, "all epilogues run inline");
#undef PG8_LANE_CONSTS
#undef PG8_SA
#undef PG8_SB
#undef PG8_STAGE
#undef PG8_LDA
#undef PG8_LDB
#undef PG8_MMA
#undef PG8_WAIT_V
#undef PG8_WAIT_L
#undef PG8_BAR
#undef PG8_SCHED
}


struct EpiZ {
    static constexpr bool PERM = true, AFTER_DRAIN = false;
    bf16_t* zmain; bf16_t* apr; const float* bias;
    __device__ __forceinline__ void operator()(const f32x4 (&acc)[2][2][4][2], const Unit& u, int wr, int wc, int fr_, int fq_) const {
        const int ln_ = fresh_lane(), fr = ln_ & 15, fq = ln_ >> 4;
        int row0 = u.pm * BM + wr * 64 + fr, cl = wc * 32 + 8 * fq; asm volatile("" : "+v"(row0));
        const int pn = u.pn;
        if (pn == 2 || pn == 3 || pn == 6) {
            const int sbase = pn == 2 ? 256 : (pn == 3 ? 768 : 1536), obase = pn == 2 ? 256 : 512;
#pragma unroll
            for (int bj = 0; bj < 2; ++bj) {
                const int c = bj * HALF + cl;
                const f32x4 b0 = *(const f32x4*)(bias + sbase + c), b1 = *(const f32x4*)(bias + sbase + c + 4);
#pragma unroll
                for (int ai = 0; ai < 2; ++ai)
#pragma unroll
                    for (int m = 0; m < 4; ++m) {
                        const int row = row0 + ai * HALF + m * 16;
                        const f32x4 v0 = acc[ai][bj][m][0] + b0, v1 = acc[ai][bj][m][1] + b1;
                        u32x4 w; w.x = cvt_pk_bf16(v0[0], v0[1]); w.y = cvt_pk_bf16(v0[2], v0[3]); w.z = cvt_pk_bf16(v1[0], v1[1]); w.w = cvt_pk_bf16(v1[2], v1[3]);
                        if (pn != 6) *(u32x4*)(zmain + (size_t)row * ZW + obase + c) = w;
                        else { const int gq = c >> 4, h0 = c & 15;
                            *(u32x4*)(apr + ((size_t)(gq * NBC + (row >> 5)) * KSSM + (row & 31) * 16 + h0)) = w; }
                    }
            }
        } else {
            const bool glu = pn >= 4; const int hc = (pn & 1) * HALF + cl;
            const int sa = glu ? 1024 : 0, sb = glu ? 1280 : 512, obase = glu ? 768 : 0;
            const f32x4 a0 = *(const f32x4*)(bias + sa + hc), a1 = *(const f32x4*)(bias + sa + hc + 4), c0 = *(const f32x4*)(bias + sb + hc), c1 = *(const f32x4*)(bias + sb + hc + 4);
#pragma unroll
            for (int ai = 0; ai < 2; ++ai)
#pragma unroll
                for (int m = 0; m < 4; ++m) {
                    const int row = row0 + ai * HALF + m * 16;
                    const f32x4 x0 = acc[ai][0][m][0] + a0, x1 = acc[ai][0][m][1] + a1, y0 = acc[ai][1][m][0] + c0, y1 = acc[ai][1][m][1] + c1;
                    float o[8];
                    if (glu) { o[0] = x0[0] * sigmoidf_(y0[0]); o[1] = x0[1] * sigmoidf_(y0[1]); o[2] = x0[2] * sigmoidf_(y0[2]); o[3] = x0[3] * sigmoidf_(y0[3]);
                               o[4] = x1[0] * sigmoidf_(y1[0]); o[5] = x1[1] * sigmoidf_(y1[1]); o[6] = x1[2] * sigmoidf_(y1[2]); o[7] = x1[3] * sigmoidf_(y1[3]); }
                    else { o[0] = x0[0] * y0[0]; o[1] = x0[1] * y0[1]; o[2] = x0[2] * y0[2]; o[3] = x0[3] * y0[3]; o[4] = x1[0] * y1[0]; o[5] = x1[1] * y1[1]; o[6] = x1[2] * y1[2]; o[7] = x1[3] * y1[3]; }
                    st8(zmain + (size_t)row * ZW + obase + hc, o);
                }
        }
    }
};
struct EpiStates {
    static constexpr bool PERM = false, AFTER_DRAIN = false;
    float* S;
    __device__ __forceinline__ void operator()(const f32x4 (&acc)[2][2][4][2], const Unit& u, int wr, int wc, int fr_, int fq_) const {
        const int ln_ = fresh_lane(), fr = ln_ & 15, fq = ln_ >> 4;
        int row0 = u.pm * BM + wr * 64 + fr, c0 = wc * 32 + 4 * fq; asm volatile("" : "+v"(row0));
#pragma unroll
        for (int ai = 0; ai < 2; ++ai)
#pragma unroll
            for (int m = 0; m < 4; ++m)
#pragma unroll
                for (int n = 0; n < 2; ++n) *(f32x4*)(S + (size_t)(row0 + ai * HALF + m * 16) * 128 + c0 + n * 16) = acc[ai][0][m][n];
    }
};
struct EpiSsmOut {
    static constexpr bool PERM = true, AFTER_DRAIN = false;
    bf16_t* yg;
    __device__ __forceinline__ void operator()(const f32x4 (&acc)[2][2][4][2], const Unit& u, int wr, int wc, int fr_, int fq_) const {
        const int ln_ = fresh_lane(), fr = ln_ & 15, fq = ln_ >> 4;
        const int gq = u.pn >> 1; int R0 = u.pm * BM + wr * 64 + fr; asm volatile("" : "+v"(R0));
#pragma unroll
        for (int bj = 0; bj < 2; ++bj) {
            const int lc = (u.pn & 1) * 256 + bj * HALF + wc * 32 + 8 * fq, t = lc >> 4, h0 = lc & 15;
#pragma unroll
            for (int ai = 0; ai < 2; ++ai)
#pragma unroll
                for (int m = 0; m < 4; ++m) {
                    const int R = R0 + ai * HALF + m * 16, bc = R & (NBC - 1);
                    const f32x4 v0 = acc[ai][bj][m][0], v1 = acc[ai][bj][m][1];
                    u32x4 w; w.x = cvt_pk_bf16(gelu_tanh_(v0[0]), gelu_tanh_(v0[1])); w.y = cvt_pk_bf16(gelu_tanh_(v0[2]), gelu_tanh_(v0[3]));
                    w.z = cvt_pk_bf16(gelu_tanh_(v1[0]), gelu_tanh_(v1[1])); w.w = cvt_pk_bf16(gelu_tanh_(v1[2]), gelu_tanh_(v1[3]));
                    *(u32x4*)(yg + (size_t)(bc * CT + t) * 256 + gq * 16 + h0) = w;
                }
        }
    }
};
struct EpiGlu {
    static constexpr bool PERM = true, AFTER_DRAIN = false;
    const bf16_t* yg; bf16_t* ymix; const float* bias;
    __device__ __forceinline__ void operator()(const f32x4 (&acc)[2][2][4][2], const Unit& u, int wr, int wc, int fr_, int fq_) const {
        const int ln_ = fresh_lane(), fr = ln_ & 15, fq = ln_ >> 4;
        int row0 = u.pm * BM + wr * 64 + fr, cl = wc * 32 + 8 * fq; asm volatile("" : "+v"(row0));
#pragma unroll
        for (int bj = 0; bj < 2; ++bj) {
            const int c = bj * HALF + cl;
            const f32x4 b0 = *(const f32x4*)(bias + c), b1 = *(const f32x4*)(bias + c + 4);
            u32x4 yv[2][4];
#pragma unroll
            for (int ai = 0; ai < 2; ++ai)
#pragma unroll
                for (int m = 0; m < 4; ++m) yv[ai][m] = *(const u32x4*)(yg + (size_t)(row0 + ai * HALF + m * 16) * 256 + c);
#pragma unroll
            for (int ai = 0; ai < 2; ++ai)
#pragma unroll
                for (int m = 0; m < 4; ++m) {
                    const int row = row0 + ai * HALF + m * 16; const u32x4 w = yv[ai][m];
                    const f32x4 v0 = acc[ai][bj][m][0] + b0, v1 = acc[ai][bj][m][1] + b1;
                    float o[8];
                    o[0] = __uint_as_float(w.x << 16) * sigmoidf_(v0[0]); o[1] = __uint_as_float(w.x & 0xffff0000u) * sigmoidf_(v0[1]);
                    o[2] = __uint_as_float(w.y << 16) * sigmoidf_(v0[2]); o[3] = __uint_as_float(w.y & 0xffff0000u) * sigmoidf_(v0[3]);
                    o[4] = __uint_as_float(w.z << 16) * sigmoidf_(v1[0]); o[5] = __uint_as_float(w.z & 0xffff0000u) * sigmoidf_(v1[1]);
                    o[6] = __uint_as_float(w.w << 16) * sigmoidf_(v1[2]); o[7] = __uint_as_float(w.w & 0xffff0000u) * sigmoidf_(v1[3]);
                    st8(ymix + (size_t)row * DM + 768 + c, o);
                }
            asm volatile("" ::: "memory");
        }
    }
};
struct EpiSwiGlu {
    static constexpr bool PERM = true, AFTER_DRAIN = false;
    bf16_t* hid;
    __device__ __forceinline__ void operator()(const f32x4 (&acc)[2][2][4][2], const Unit& u, int wr, int wc, int fr_, int fq_) const {
        const int ln_ = fresh_lane(), fr = ln_ & 15, fq = ln_ >> 4;
        int row0 = u.pm * BM + wr * 64 + fr, c = u.pn * HALF + wc * 32 + 8 * fq; asm volatile("" : "+v"(row0));
#pragma unroll
        for (int ai = 0; ai < 2; ++ai)
#pragma unroll
            for (int m = 0; m < 4; ++m) {
                const int row = row0 + ai * HALF + m * 16;
                const f32x4 g0 = acc[ai][0][m][0], g1 = acc[ai][0][m][1], u0 = acc[ai][1][m][0], u1 = acc[ai][1][m][1];
                const f32x4 t0 = g0 * (-1.4426950408889634f), t1 = g1 * (-1.4426950408889634f);
                const f32x4 d0 = (f32x4){__builtin_amdgcn_exp2f(t0[0]), __builtin_amdgcn_exp2f(t0[1]), __builtin_amdgcn_exp2f(t0[2]), __builtin_amdgcn_exp2f(t0[3])} + 1.0f;
                const f32x4 d1 = (f32x4){__builtin_amdgcn_exp2f(t1[0]), __builtin_amdgcn_exp2f(t1[1]), __builtin_amdgcn_exp2f(t1[2]), __builtin_amdgcn_exp2f(t1[3])} + 1.0f;
                const f32x4 r0 = (f32x4){__builtin_amdgcn_rcpf(d0[0]), __builtin_amdgcn_rcpf(d0[1]), __builtin_amdgcn_rcpf(d0[2]), __builtin_amdgcn_rcpf(d0[3])};
                const f32x4 r1 = (f32x4){__builtin_amdgcn_rcpf(d1[0]), __builtin_amdgcn_rcpf(d1[1]), __builtin_amdgcn_rcpf(d1[2]), __builtin_amdgcn_rcpf(d1[3])};
                const f32x4 o0 = (g0 * r0) * u0, o1 = (g1 * r1) * u1;
                u32x4 w; w.x = cvt_pk_bf16(o0[0], o0[1]); w.y = cvt_pk_bf16(o0[2], o0[3]); w.z = cvt_pk_bf16(o1[0], o1[1]); w.w = cvt_pk_bf16(o1[2], o1[3]);
                __builtin_nontemporal_store(w, (u32x4*)(hid + (size_t)row * FF + c));
            }
    }
};
struct EpiLn {
    static constexpr bool PERM = true, AFTER_DRAIN = false;
    float* xout; bf16_t* h; const float* tab;
    unsigned long long* xbuf; unsigned* tmo; unsigned tag; LAS unsigned char* xl;
    __device__ __forceinline__ void operator()(f32x4 (&acc)[2][2][4][2], const Unit& u, int wr, int wc, int fr_, int fq_) const {
        const int wid = wr * 4 + wc; LAS unsigned char* lds = xl;
        const int lane = fresh_lane(), fr = lane & 15, fq = lane >> 4;
        const float* tb = tab + (u.pm >> 5) * 5120;
        const int col0 = u.pn * BM + wc * 32 + 8 * fq;
        int rloc = wr * 64 + fr; asm volatile("" : "+v"(rloc));
#pragma unroll
        for (int bj = 0; bj < 2; ++bj) {
            f32x4 gv[2], pa[2], pb[2]; u32x4 hv[2][4];
            const int colb = col0 + bj * HALF;
#pragma unroll
            for (int n = 0; n < 2; ++n) { gv[n] = *(const f32x4*)(tb + colb + 4 * n); pa[n] = *(const f32x4*)(tb + 1024 + colb + 4 * n); pb[n] = *(const f32x4*)(tb + 2048 + colb + 4 * n); }
#pragma unroll
            for (int ai = 0; ai < 2; ++ai)
#pragma unroll
                for (int m = 0; m < 4; ++m) hv[ai][m] = *(const u32x4*)(h + (size_t)(u.pm * BM + rloc + ai * HALF + m * 16) * DM + colb);
#pragma unroll
            for (int ai = 0; ai < 2; ++ai)
#pragma unroll
                for (int m = 0; m < 4; ++m) {
                    const u32x4 w = hv[ai][m];
                    const f32x4 hx0 = (f32x4){__uint_as_float(w.x << 16), __uint_as_float(w.x & 0xffff0000u), __uint_as_float(w.y << 16), __uint_as_float(w.y & 0xffff0000u)};
                    const f32x4 hx1 = (f32x4){__uint_as_float(w.z << 16), __uint_as_float(w.z & 0xffff0000u), __uint_as_float(w.w << 16), __uint_as_float(w.w & 0xffff0000u)};
                    acc[ai][bj][m][0] = hx0 * pa[0] + (gv[0] * acc[ai][bj][m][0] - pb[0]);
                    acc[ai][bj][m][1] = hx1 * pa[1] + (gv[1] * acc[ai][bj][m][1] - pb[1]);
                    asm volatile("" : "+v"(acc[ai][bj][m][0]), "+v"(acc[ai][bj][m][1]));
                }
            asm volatile("" ::: "memory");
        }
        f32x4 oa[2][2], ob[2][2];
#pragma unroll
        for (int bj = 0; bj < 2; ++bj)
#pragma unroll
            for (int n = 0; n < 2; ++n) {
                const int col = col0 + bj * HALF + 4 * n;
                oa[bj][n] = *(const f32x4*)(tb + 3072 + col); ob[bj][n] = *(const f32x4*)(tb + 4096 + col);
            }
        LAS f32x2* P = (LAS f32x2*)lds;
        LAS f32x2* Sx = (LAS f32x2*)(lds + 8192);
#pragma unroll
        for (int ai = 0; ai < 2; ++ai)
#pragma unroll
            for (int m = 0; m < 4; ++m) {
                f32x4 s4 = (f32x4){0.f, 0.f, 0.f, 0.f}, q4 = s4;
#pragma unroll
                for (int bj = 0; bj < 2; ++bj)
#pragma unroll
                    for (int n = 0; n < 2; ++n) { const f32x4 v = acc[ai][bj][m][n]; s4 += v; q4 += v * v; }
                float s = (s4[0] + s4[1]) + (s4[2] + s4[3]), q = (q4[0] + q4[1]) + (q4[2] + q4[3]);
                s = sum_x16_x32(s); q = sum_x16_x32(q);
                if (fq == 0) P[(ai * HALF + rloc + m * 16) * 4 + wc] = (f32x2){s, q};
            }
        asm volatile("s_waitcnt lgkmcnt(0)" ::: "memory"); __builtin_amdgcn_s_barrier(); asm volatile("" ::: "memory");
        const int row = wid * 32 + (lane & 31);
        if (lane < 32) {
            const f32x2 a = P[row * 4 + 0], bq = P[row * 4 + 1], c = P[row * 4 + 2], d = P[row * 4 + 3];
            const float s1 = (a.x + bq.x) + (c.x + d.x), s2 = (a.y + bq.y) + (c.y + d.y);
            unsigned long long* slot = xbuf + (size_t)(u.pm * BM + row) * 4;
            __hip_atomic_store(slot + u.pn, ((unsigned long long)((__float_as_uint(s2) & ~7u) | tag) << 32) | __float_as_uint(s1), __ATOMIC_RELAXED, __HIP_MEMORY_SCOPE_AGENT);
            unsigned long long w0, w1, w2, w3; unsigned sp = 0;
            for (;;) {
                w0 = __hip_atomic_load(slot + 0, __ATOMIC_RELAXED, __HIP_MEMORY_SCOPE_AGENT); w1 = __hip_atomic_load(slot + 1, __ATOMIC_RELAXED, __HIP_MEMORY_SCOPE_AGENT);
                w2 = __hip_atomic_load(slot + 2, __ATOMIC_RELAXED, __HIP_MEMORY_SCOPE_AGENT); w3 = __hip_atomic_load(slot + 3, __ATOMIC_RELAXED, __HIP_MEMORY_SCOPE_AGENT);
                const unsigned t0 = (unsigned)(w0 >> 32) & 7u, t1 = (unsigned)(w1 >> 32) & 7u, t2 = (unsigned)(w2 >> 32) & 7u, t3 = (unsigned)(w3 >> 32) & 7u;
                if (t0 == tag && t1 == tag && t2 == tag && t3 == tag) break;
                if (++sp > (1u << 20)) { __hip_atomic_store(tmo, 1u, __ATOMIC_RELAXED, __HIP_MEMORY_SCOPE_AGENT); break; }
                __builtin_amdgcn_s_sleep(1);
            }
            const float T1 = (__uint_as_float((unsigned)w0) + __uint_as_float((unsigned)w1)) + (__uint_as_float((unsigned)w2) + __uint_as_float((unsigned)w3));
            const float T2 = (__uint_as_float((unsigned)(w0 >> 32) & ~7u) + __uint_as_float((unsigned)(w1 >> 32) & ~7u)) + (__uint_as_float((unsigned)(w2 >> 32) & ~7u) + __uint_as_float((unsigned)(w3 >> 32) & ~7u));
            const float mean = T1 * (1.0f / 1024.0f); float var = T2 * (1.0f / 1024.0f) - mean * mean; var = var > 0.f ? var : 0.f;
            Sx[row] = (f32x2){mean, __builtin_amdgcn_rsqf(var + LN_EPS)};
        }
        asm volatile("s_waitcnt lgkmcnt(0)" ::: "memory"); __builtin_amdgcn_s_barrier(); asm volatile("" ::: "memory");
        asm volatile("" : "+v"(rloc));
#pragma unroll
        for (int bj = 0; bj < 2; ++bj)
#pragma unroll
            for (int ai = 0; ai < 2; ++ai)
#pragma unroll
                for (int m = 0; m < 4; ++m) {
                    const int r = ai * HALF + rloc + m * 16; const f32x2 sr = Sx[r];
                    const size_t off = (size_t)(u.pm * BM + r) * DM + col0 + bj * HALF;
                    const f32x4 o0 = (acc[ai][bj][m][0] - sr.x) * sr.y * oa[bj][0] + ob[bj][0];
                    const f32x4 o1 = (acc[ai][bj][m][1] - sr.x) * sr.y * oa[bj][1] + ob[bj][1];
                    if (xout) { *(f32x4*)(xout + off) = o0; *(f32x4*)(xout + off + 4) = o1; }
                    else { u32x4 w; w.x = cvt_pk_bf16(o0[0], o0[1]); w.y = cvt_pk_bf16(o0[2], o0[3]); w.z = cvt_pk_bf16(o1[0], o1[1]); w.w = cvt_pk_bf16(o1[2], o1[3]); *(u32x4*)(h + off) = w; }
                }
    }
};
}

struct Args { const float* in[31]; float* out; unsigned char* ws; };
#define CAS __attribute__((address_space(4)))
__device__ __forceinline__ const CAS Args* fresh_args() { const CAS Args* p = (const CAS Args*)__builtin_amdgcn_kernarg_segment_ptr(); asm volatile("" : "+s"(p)); return p; }
#define PH_PTRS0 const int l_ = 0; PH_PTRS_(l_)
#define PH_PTRS PH_PTRS_(l)
#define PH_PTRS_(l) \
    const CAS Args* ka = fresh_args(); unsigned char* ws = ka->ws; \
    [[maybe_unused]] unsigned* ctl = (unsigned*)(ws + WS_CTL); [[maybe_unused]] float* mod = (float*)(ws + WS_MOD); \
    [[maybe_unused]] f32x2* pw = (f32x2*)(ws + WS_PW); [[maybe_unused]] f32x2* bbar = (f32x2*)(ws + WS_BBAR); [[maybe_unused]] float* Kk = (float*)(ws + WS_KK); \
    [[maybe_unused]] bf16_t* win_t = (bf16_t*)(ws + WS_WIN); [[maybe_unused]] bf16_t* wo_t = (bf16_t*)(ws + WS_WO); [[maybe_unused]] bf16_t* wgu_t = (bf16_t*)(ws + WS_WGU); \
    [[maybe_unused]] bf16_t* wdn_t = (bf16_t*)(ws + WS_WDN); [[maybe_unused]] bf16_t* wglu_t = (bf16_t*)(ws + WS_WGLU); \
    [[maybe_unused]] bf16_t* btout = (bf16_t*)(ws + WS_BTOUT); [[maybe_unused]] bf16_t* w1m = (bf16_t*)(ws + WS_W1); \
    [[maybe_unused]] bf16_t* hmod = (bf16_t*)(ws + WS_HMOD); [[maybe_unused]] bf16_t* zmain = (bf16_t*)(ws + WS_ZMAIN); [[maybe_unused]] bf16_t* apr = (bf16_t*)(ws + WS_APR); \
    [[maybe_unused]] float* Sst = (float*)(ws + WS_S); [[maybe_unused]] bf16_t* yg = (bf16_t*)(ws + WS_YG); [[maybe_unused]] bf16_t* ymix = (bf16_t*)(ws + WS_YMIX); [[maybe_unused]] bf16_t* hid = (bf16_t*)(ws + WS_HID); \
    [[maybe_unused]] float* xres = ka->out; [[maybe_unused]] const float* modl = mod + (size_t)l * 8 * 6144;

#define XB_TMO      128
#define XB_XCNT(j)  (256  + 64 * (j))
#define XB_XSUB(j)  (1280 + 64 * (j))
#define XB_XGEN(j)  (2304 + 64 * (j))
#define XB_TOP      3328
#define XB_TOPGEN   3392
#define XB_SPIN_CAP (1u << 18)
constexpr int XB_LDS_OFF = 131072 + 14336;
__device__ __forceinline__ unsigned xb_ld(unsigned* p)              { return __hip_atomic_load(p, __ATOMIC_RELAXED, __HIP_MEMORY_SCOPE_AGENT); }
__device__ __forceinline__ unsigned xb_add(unsigned* p, unsigned v) { return __hip_atomic_fetch_add(p, v, __ATOMIC_RELAXED, __HIP_MEMORY_SCOPE_AGENT); }
__device__ __forceinline__ unsigned xb_xcc_id() { return (unsigned)__builtin_amdgcn_s_getreg((3 << 11) | 20) & 0xFu; }
#define XB_SPIN(cond, bar) do { unsigned _sp = 0; while (cond) { __builtin_amdgcn_s_sleep(1); \
    if ((++_sp & 255u) == 0u) { if (xb_ld(&(bar)[XB_TMO])) break; if (_sp > XB_SPIN_CAP) { atomicAdd(&(bar)[XB_TMO], 1u); break; } } } } while (0)
__device__ __forceinline__ void xcd_barrier_complete(unsigned* bar, unsigned x, unsigned& nloc, unsigned& nx) {
    const unsigned G = (unsigned)GRID;
    unsigned sum, cnt, mine, sp = 0u;
    for (;;) {
        sum = 0u; cnt = 0u; mine = 0u;
#pragma unroll
        for (unsigned j = 0; j < 16; ++j) { const unsigned c = xb_ld(&bar[XB_XCNT(j)]); sum += c; cnt += (c > 0u) ? 1u : 0u; mine = (j == x) ? c : mine; }
        if (sum == G) break;
        __builtin_amdgcn_s_sleep(1);
        if ((++sp & 255u) == 0u) { if (xb_ld(&bar[XB_TMO])) break; if (sp > XB_SPIN_CAP) { atomicAdd(&bar[XB_TMO], 1u); break; } }
    }
    nloc = mine > 0u ? mine : 1u; nx = cnt > 0u ? cnt : 1u;
}
__device__ __forceinline__ void grid_bar(int wave, unsigned char* smem) {
    asm volatile("s_waitcnt vmcnt(0)" ::: "memory");
    __syncthreads();
    asm volatile("" : "+s"(wave));
    if (wave == 0 && fresh_lane() == 0) {
        const CAS Args* ka = fresh_args(); unsigned* bar = (unsigned*)(ka->ws + WS_CTL) + CW_XB;
        volatile LAS unsigned* st = (volatile LAS unsigned*)((LAS unsigned char*)smem + XB_LDS_OFF);
        const unsigned x = xb_xcc_id();
        __builtin_amdgcn_s_waitcnt(0);
        unsigned nloc = st[0], nx = st[1];
        if (nloc == 0u) { xcd_barrier_complete(bar, x, nloc, nx); st[0] = nloc; st[1] = nx; }
        const unsigned old = xb_add(&bar[XB_XSUB(x)], 1u);
        const unsigned gen = old / nloc;
        if (old + 1u == (gen + 1u) * nloc) {
            __builtin_amdgcn_fence(__ATOMIC_RELEASE, "agent");
            asm volatile("s_waitcnt vmcnt(0)" ::: "memory");
            const unsigned og = xb_add(&bar[XB_TOP], 1u);
            const unsigned tg = og / nx;
            if (og + 1u == (tg + 1u) * nx) xb_add(&bar[XB_TOPGEN], 1u);
            else XB_SPIN(xb_ld(&bar[XB_TOPGEN]) == tg, bar);
            __builtin_amdgcn_fence(__ATOMIC_ACQUIRE, "agent");
            xb_add(&bar[XB_XGEN(x)], 1u);
            asm volatile("s_waitcnt vmcnt(0)" ::: "memory");
        } else {
            XB_SPIN(xb_ld(&bar[XB_XGEN(x)]) == gen, bar);
            __builtin_amdgcn_fence(__ATOMIC_ACQUIRE, "agent");
            asm volatile("s_waitcnt vmcnt(0)" ::: "memory");
        }
    }
    __syncthreads();
}
#define PH_T0() unsigned long long ph_t0_ = 0; if (AMP_MASK) ph_t0_ = __builtin_amdgcn_s_memrealtime()
#define PH_AMP(i) do { if (AMP_MASK & (1u << (i))) { const unsigned long long t1_ = __builtin_amdgcn_s_memrealtime(); while (__builtin_amdgcn_s_memrealtime() - t1_ < t1_ - ph_t0_) __builtin_amdgcn_s_sleep(8); } } while (0)
__device__ __forceinline__ void transpose_item(const float* W, int K, int N, bf16_t* WT, int mode, float* scr, int item, int lane) {
    const int nblk = N / 32, kb = item / nblk, nb = item % nblk, k0 = 64 * kb, n0 = 32 * nb;
    int drow0 = mode == 0 ? n0 : (256 * (n0 >> 7) + (n0 & 127) + (mode == 2 ? 128 : 0));
    if (mode == 3) {
        const int seg = n0 >> 8, c = n0 & 255, pr = 256 * (c >> 7) + (c & 127);
        drow0 = seg == 0 ? pr : seg == 1 ? 512 + c : seg == 2 ? pr + 128 : seg == 3 ? 768 + c : seg == 4 ? 1024 + pr : seg == 5 ? 1024 + pr + 128 : n0;
    }
    float wv_[32];
#pragma unroll
    for (int i = 0; i < 32; ++i) wv_[i] = W[(size_t)(k0 + 2 * i + (lane >> 5)) * N + n0 + (lane & 31)];
#pragma unroll
    for (int i = 0; i < 32; ++i) scr[(2 * i + (lane >> 5)) * 33 + (lane & 31)] = wv_[i];
    asm volatile("s_waitcnt lgkmcnt(0)" ::: "memory");
    const int c = lane & 7;
#pragma unroll
    for (int j = 0; j < 4; ++j) { const int n = (lane >> 3) + 8 * j; const float* s = scr + (8 * c) * 33 + n;
        u32x4 o; o.x = cvt_pk_bf16(s[0 * 33], s[1 * 33]); o.y = cvt_pk_bf16(s[2 * 33], s[3 * 33]); o.z = cvt_pk_bf16(s[4 * 33], s[5 * 33]); o.w = cvt_pk_bf16(s[6 * 33], s[7 * 33]);
        *(u32x4*)(WT + (size_t)(drow0 + n) * K + k0 + 8 * c) = o; }
    asm volatile("s_waitcnt lgkmcnt(0)" ::: "memory");
}

__device__ __forceinline__ void fused_pool_item(const float* W, const float* poolw, const float* scale, bf16_t* WT, float* scr, int item, int lane) {
    const int K = DM, N = DM, nblk = N / 32, kb = item / nblk, nb = item % nblk, k0 = 64 * kb, n0 = 32 * nb;
    const int n = lane & 31, half = lane >> 5;
    float a[32];
#pragma unroll
    for (int i = 0; i < 32; ++i) a[i] = 0.f;
    for (int d = 0; d < 64; ++d) {
        const float wv = W[(size_t)(k0 + d) * N + n0 + n] * scale[d];
#pragma unroll
        for (int i = 0; i < 32; ++i) a[i] += poolw[(2 * i + half) * 64 + d] * wv;
    }
#pragma unroll
    for (int i = 0; i < 32; ++i) scr[(2 * i + half) * 33 + n] = a[i];
    asm volatile("s_waitcnt lgkmcnt(0)" ::: "memory");
    const int c = lane & 7;
#pragma unroll
    for (int j = 0; j < 4; ++j) { const int nn = (lane >> 3) + 8 * j; const float* s = scr + (8 * c) * 33 + nn;
        u32x4 o; o.x = cvt_pk_bf16(s[0 * 33], s[1 * 33]); o.y = cvt_pk_bf16(s[2 * 33], s[3 * 33]); o.z = cvt_pk_bf16(s[4 * 33], s[5 * 33]); o.w = cvt_pk_bf16(s[6 * 33], s[7 * 33]);
        *(u32x4*)(WT + (size_t)(n0 + nn) * K + k0 + 8 * c) = o; }
    asm volatile("s_waitcnt lgkmcnt(0)" ::: "memory");
}

__device__ __forceinline__ void unpack8(const u32x4 w, float (&f)[8]) {
    f[0] = __uint_as_float(w.x << 16); f[1] = __uint_as_float(w.x & 0xffff0000u); f[2] = __uint_as_float(w.y << 16); f[3] = __uint_as_float(w.y & 0xffff0000u);
    f[4] = __uint_as_float(w.z << 16); f[5] = __uint_as_float(w.z & 0xffff0000u); f[6] = __uint_as_float(w.w << 16); f[7] = __uint_as_float(w.w & 0xffff0000u);
}
struct MixRaw { u32x4 ra[2][4], rb[3], rc[4]; };
__device__ __forceinline__ void mix_load(MixRaw& R, int item, const bf16_t* zm, int tq, int ch) {
    const int b = item >> 8, s0 = (item & 255) * 32; const size_t row0 = (size_t)b * SEQ + s0;
    const u32x4 zero4 = (u32x4){0u, 0u, 0u, 0u};
#pragma unroll
    for (int it = 0; it < 2; ++it) { const int tk = tq + 16 * it, s = s0 + tk; const size_t row = row0 + tk;
        R.ra[it][0] = *(const u32x4*)(zm + row * ZW + 256 + ch);
#pragma unroll
        for (int k = 0; k < 3; ++k) R.ra[it][1 + k] = (s - 2 + k >= 0) ? *(const u32x4*)(zm + (row - 2 + k) * ZW + ch) : zero4; }
#pragma unroll
    for (int it = 0; it < 3; ++it) { const int j = tq + 16 * it; R.rb[it] = (s0 - 16 + j >= 0) ? *(const u32x4*)(zm + (row0 + j - 16) * ZW + 512 + ch) : zero4; }
#pragma unroll
    for (int it = 0; it < 4; ++it) { const int j = tq + 16 * it; R.rc[it] = (j < 62 && s0 - 30 + j >= 0) ? *(const u32x4*)(zm + (row0 + j - 30) * ZW + 768 + ch) : zero4; }
}
__device__ __forceinline__ void mixers_run(int it0, int it1, const bf16_t* zm, bf16_t* ymix, const float* scw,
                                           const float* dww, const float* dwb, const float* clg, const float* clb, unsigned char* smem, int wv) {
    const int lane = fresh_lane(), tid = wv * 64 + lane;
    const int ch = (tid & 31) * 8, tq = tid >> 5;
    const int c = tid & 255, th = tid >> 8;
    float* P = (float*)smem;
    float* H = (float*)(smem + 49152);
    float* O = (float*)(smem + 112640);
    f32x4 wa0[3], wa1[3]; float w[31];
#pragma unroll
    for (int k = 0; k < 3; ++k) { wa0[k] = *(const f32x4*)(scw + k * 256 + ch); wa1[k] = *(const f32x4*)(scw + k * 256 + ch + 4); }
#pragma unroll
    for (int k = 0; k < 31; ++k) w[k] = dww[k * 256 + c];
    const float bias = dwb[c];
    const f32x4 gq = *(const f32x4*)(clg + 4 * lane), bq = *(const f32x4*)(clb + 4 * lane);
    MixRaw R;
    if (it0 < it1) mix_load(R, it0, zm, tq, ch);
    for (int item = it0; item < it1; ++item) {
        const int b = item >> 8, s0 = (item & 255) * 32; const size_t row0 = (size_t)b * SEQ + s0;
#pragma unroll
        for (int it = 0; it < 3; ++it) { const int j = tq + 16 * it; float v[8]; unpack8(R.rb[it], v);
            *(f32x4*)(P + j * 256 + ch) = (f32x4){v[0], v[1], v[2], v[3]}; *(f32x4*)(P + j * 256 + ch + 4) = (f32x4){v[4], v[5], v[6], v[7]}; }
#pragma unroll
        for (int it = 0; it < 4; ++it) { const int j = tq + 16 * it; if (j < 62) { float v[8]; unpack8(R.rc[it], v);
            *(f32x4*)(H + j * 256 + ch) = (f32x4){v[0], v[1], v[2], v[3]}; *(f32x4*)(H + j * 256 + ch + 4) = (f32x4){v[4], v[5], v[6], v[7]}; } }
        __syncthreads();
#pragma unroll
        for (int it = 0; it < 2; ++it) {
            float zb[8], a[8]; unpack8(R.ra[it][0], zb);
#pragma unroll
            for (int j = 0; j < 8; ++j) a[j] = 0.f;
#pragma unroll
            for (int k = 0; k < 3; ++k) { float pz[8]; unpack8(R.ra[it][1 + k], pz);
                a[0] += wa0[k][0] * pz[0]; a[1] += wa0[k][1] * pz[1]; a[2] += wa0[k][2] * pz[2]; a[3] += wa0[k][3] * pz[3];
                a[4] += wa1[k][0] * pz[4]; a[5] += wa1[k][1] * pz[5]; a[6] += wa1[k][2] * pz[6]; a[7] += wa1[k][3] * pz[7]; }
#pragma unroll
            for (int j = 0; j < 8; ++j) a[j] *= zb[j];
            st8(ymix + (row0 + tq + 16 * it) * DM + ch, a);
        }
        if (item + 1 < it1) mix_load(R, item + 1, zm, tq, ch);
        {
            const int gI = wv >> 1, ww = 2 << gI, chb = gI * 64 + (lane & 7) * 8, tl = (lane >> 3) + 8 * (wv & 1);
#pragma unroll
            for (int it = 0; it < 2; ++it) {
                const int t = tl + 16 * it, s = s0 + t; const int cntv = (s + 1 < ww) ? (s + 1) : ww;
                f32x4 a0 = (f32x4){0.f, 0.f, 0.f, 0.f}, a1 = a0;
                for (int j = 0; j < ww; ++j) { a0 += *(const f32x4*)(P + (16 + t - j) * 256 + chb); a1 += *(const f32x4*)(P + (16 + t - j) * 256 + chb + 4); }
                const float inv = __builtin_amdgcn_rcpf((float)cntv);
                const f32x4 z0 = *(const f32x4*)(P + (16 + t) * 256 + chb), z1 = *(const f32x4*)(P + (16 + t) * 256 + chb + 4);
                a0 = a0 * inv - z0; a1 = a1 * inv - z1;
                float o[8] = {a0[0], a0[1], a0[2], a0[3], a1[0], a1[1], a1[2], a1[3]};
                st8(ymix + (row0 + t) * DM + 256 + chb, o);
            }
        }
        {
            float win[46];
#pragma unroll
            for (int q = 0; q < 46; ++q) win[q] = H[(th * 16 + q) * 256 + c];
#pragma unroll
            for (int j = 0; j < 16; ++j) { float o = bias;
#pragma unroll
                for (int k = 0; k < 31; ++k) o += w[k] * win[j + k];
                O[(th * 16 + j) * 256 + c] = o; }
        }
        __syncthreads();
#pragma unroll
        for (int q = 0; q < 4; ++q) {
            const int t = wv * 4 + q; const f32x4 v = *(const f32x4*)(O + t * 256 + 4 * lane);
            const float mean = wave_sum((v[0] + v[1]) + (v[2] + v[3]), lane) * (1.0f / 256.0f);
            const f32x4 d = v - mean;
            const float var = wave_sum((d[0] * d[0] + d[1] * d[1]) + (d[2] * d[2] + d[3] * d[3]), lane) * (1.0f / 256.0f);
            const float rstd = 1.0f / sqrtf(var + LN_EPS);
            const f32x4 y = d * rstd * gq + bq;
            u32x2 o; o.x = cvt_pk_bf16(siluf_(y[0]), siluf_(y[1])); o.y = cvt_pk_bf16(siluf_(y[2]), siluf_(y[3]));
            *(u32x2*)(ymix + (row0 + t) * DM + 512 + 4 * lane) = o;
        }
        __syncthreads();
    }
}

__global__ void __launch_bounds__(NTHREADS, 2) trunk_fwd(Args args) {
    extern __shared__ __attribute__((aligned(16))) unsigned char smem[];
    cg::grid_group grid = cg::this_grid();
    LAS unsigned char* lds = (LAS unsigned char*)smem;
    const int tid = threadIdx.x, lane = tid & 63, wave = __builtin_amdgcn_readfirstlane(tid >> 6);
    const int bid = blockIdx.x, G = gridDim.x;
    const int gtid = bid * NTHREADS + tid, GT = G * NTHREADS;

    if (tid < 4) ((unsigned*)(smem + XB_LDS_OFF))[tid] = 0u;
    if (tid == 0) (void)xb_add((unsigned*)(args.ws + WS_CTL) + CW_XB + XB_XCNT(xb_xcc_id()), 1u);
    __syncthreads();
    PH_T0();
    {
        PH_PTRS0
        float* scr = (float*)(smem + wave * 16384);
        const int gw = bid * 8 + wave, NGW = G * 8;
        constexpr int I_IN = 16 * 56, I_O = 16 * 32, I_G = 16 * 88, I_D = 44 * 32, I_GLU = 4 * 8, I_L = I_IN + I_O + 2 * I_G + I_D + I_GLU;
        for (int it = gw; it < DEPTH * I_L; it += NGW) {
            const int l = it / I_L; int r = it % I_L;
            if (r < I_IN) { transpose_item(ka->in[4] + (size_t)l * DM * INW, DM, INW, win_t + (size_t)l * INW * DM, 3, scr, r, lane); continue; } r -= I_IN;
            if (r < I_O) {
                const int kb = r / 32;
                if (kb >= 4 && kb < 8) fused_pool_item(ka->in[23] + (size_t)l * DM * DM, ka->in[7] + (size_t)l * 16384 + (kb - 4) * 4096, ka->in[8] + l * 256 + (kb - 4) * 64, wo_t + (size_t)l * DM * DM, scr, r, lane);
                else transpose_item(ka->in[23] + (size_t)l * DM * DM, DM, DM, wo_t + (size_t)l * DM * DM, 0, scr, r, lane);
                continue; } r -= I_O;
            if (r < I_G) { transpose_item(ka->in[26] + (size_t)l * DM * FF, DM, FF, wgu_t + (size_t)l * 2 * FF * DM, 1, scr, r, lane); continue; } r -= I_G;
            if (r < I_G) { transpose_item(ka->in[27] + (size_t)l * DM * FF, DM, FF, wgu_t + (size_t)l * 2 * FF * DM, 2, scr, r, lane); continue; } r -= I_G;
            if (r < I_D) { transpose_item(ka->in[28] + (size_t)l * FF * DM, FF, DM, wdn_t + (size_t)l * DM * FF, 0, scr, r, lane); continue; } r -= I_D;
            transpose_item(ka->in[21] + (size_t)l * 65536, 256, 256, wglu_t + (size_t)l * 65536, 0, scr, r, lane);
        }
        __syncthreads();
        float* cond = (float*)smem; float* red = (float*)(smem + 32768);
        for (int i = tid; i < NB * DM; i += NTHREADS) { const float v = ka->in[1][i]; cond[i] = siluf_(v); }
        __syncthreads();
        for (int item = bid; item < DEPTH * 96; item += G) {
            const int l = item / 96, n = (item % 96) * 64 + lane;
            const float* Wp = ka->in[2] + (size_t)l * DM * 6144 + n;
            float a[8];
#pragma unroll
            for (int q = 0; q < 8; ++q) a[q] = 0.f;
            for (int k0 = wave * 128; k0 < wave * 128 + 128; k0 += 16) {
                float wv_[16];
#pragma unroll
                for (int j = 0; j < 16; ++j) wv_[j] = Wp[(size_t)(k0 + j) * 6144];
#pragma unroll
                for (int j = 0; j < 16; ++j)
#pragma unroll
                    for (int q = 0; q < 8; ++q) a[q] += cond[q * DM + k0 + j] * wv_[j];
            }
#pragma unroll
            for (int q = 0; q < 8; ++q) red[(wave * 8 + q) * 64 + lane] = a[q];
            __syncthreads();
            float s = 0.f;
#pragma unroll
            for (int w2 = 0; w2 < 8; ++w2) s += red[(w2 * 8 + wave) * 64 + lane];
            mod[(size_t)(l * 8 + wave) * 6144 + n] = s + ka->in[3][l * 6144 + n];
            __syncthreads();
        }
        if (gtid < DEPTH * 16 * 64) {
            const int idx = gtid, lg = idx >> 6;
            const float dt = __expf(ka->in[15][lg]), lr = ka->in[13][idx], li = ka->in[14][idx];
            const float a = lr * dt, tt = li * dt * 0.15915494309189535f;
            float lbr = 0.f, lbi = 0.f;
            for (int k = 0; k <= 32; ++k) {
                const float mag = __expf((float)k * a), tk = (float)k * tt, frc = tk - rintf(tk);
                const float cr = mag * __builtin_amdgcn_cosf(frc), ci = mag * __builtin_amdgcn_sinf(frc);
                pw[idx * 33 + k] = (f32x2){cr, ci};
                if (k == 1) { lbr = cr; lbi = ci; }
            }
            const float nr = lbr - 1.0f, ni = lbi, inv = 1.0f / (lr * lr + li * li);
            const float qr = (nr * lr + ni * li) * inv, qi = (ni * lr - nr * li) * inv;
            for (int h = 0; h < 16; ++h) { const float br = ka->in[16][idx * 16 + h], bi = ka->in[17][idx * 16 + h];
                bbar[idx * 16 + h] = (f32x2){qr * br - qi * bi, qr * bi + qi * br}; }
        }
    }
    grid.sync();
    {
        PH_PTRS0
        for (int idx = gtid; idx < DEPTH * 16 * 32 * 256; idx += GT) {
            const int hp = idx & 15, h = (idx >> 4) & 15, k = (idx >> 8) & 31, lg = idx >> 13;
            const float* cre = ka->in[18] + (size_t)(lg * 16 + h) * 64; const float* cim = ka->in[19] + (size_t)(lg * 16 + h) * 64;
            float sum = 0.f;
            for (int p = 0; p < 64; ++p) { const f32x2 w = pw[(lg * 64 + p) * 33 + k], bb = bbar[(lg * 64 + p) * 16 + hp];
                const float tr = w.x * bb.x - w.y * bb.y, ti = w.x * bb.y + w.y * bb.x; sum += cre[p] * tr - cim[p] * ti; }
            Kk[idx] = sum;
        }
        for (int idx = gtid; idx < DEPTH * 16 * 256 * 32; idx += GT) {
            const int s = idx & 31, row = (idx >> 5) & 255, lg = idx >> 13;
            bf16_t* dst = w1m + ((size_t)(lg * 256 + row) * 512 + s * 16);
            float v[16];
            if (row < 128) { const int p = row >> 1, ri = row & 1; const f32x2 w = pw[(lg * 64 + p) * 33 + (31 - s)];
#pragma unroll
                for (int hp = 0; hp < 16; ++hp) { const f32x2 bb = bbar[(lg * 64 + p) * 16 + hp]; v[hp] = ri ? (w.x * bb.y + w.y * bb.x) : (w.x * bb.x - w.y * bb.y); } }
            else {
#pragma unroll
                for (int hp = 0; hp < 16; ++hp) v[hp] = 0.f;
            }
            u32x4 o0, o1; o0.x = cvt_pk_bf16(v[0], v[1]); o0.y = cvt_pk_bf16(v[2], v[3]); o0.z = cvt_pk_bf16(v[4], v[5]); o0.w = cvt_pk_bf16(v[6], v[7]);
            o1.x = cvt_pk_bf16(v[8], v[9]); o1.y = cvt_pk_bf16(v[10], v[11]); o1.z = cvt_pk_bf16(v[12], v[13]); o1.w = cvt_pk_bf16(v[14], v[15]);
            *(u32x4*)dst = o0; *(u32x4*)(dst + 8) = o1;
        }
        for (int idx = gtid; idx < DEPTH * 16 * 32 * 16 * 8; idx += GT) {
            const int pc = idx & 7, h = (idx >> 3) & 15, t = (idx >> 7) & 31, lg = idx >> 12;
            bf16_t* dst = btout + ((size_t)(lg * 512 + t * 16 + h) * KSSM + 512 + pc * 16);
            const float* cre = ka->in[18] + (size_t)(lg * 16 + h) * 64 + pc * 8; const float* cim = ka->in[19] + (size_t)(lg * 16 + h) * 64 + pc * 8;
            float v[16];
#pragma unroll
            for (int j = 0; j < 8; ++j) { const f32x2 w = pw[(lg * 64 + pc * 8 + j) * 33 + t + 1]; const float cr = cre[j], ci = cim[j];
                v[2 * j] = cr * w.x - ci * w.y; v[2 * j + 1] = -(cr * w.y + ci * w.x); }
            u32x4 o0, o1; o0.x = cvt_pk_bf16(v[0], v[1]); o0.y = cvt_pk_bf16(v[2], v[3]); o0.z = cvt_pk_bf16(v[4], v[5]); o0.w = cvt_pk_bf16(v[6], v[7]);
            o1.x = cvt_pk_bf16(v[8], v[9]); o1.y = cvt_pk_bf16(v[10], v[11]); o1.z = cvt_pk_bf16(v[12], v[13]); o1.w = cvt_pk_bf16(v[14], v[15]);
            *(u32x4*)dst = o0; *(u32x4*)(dst + 8) = o1;
        }
        for (int idx = gtid; idx < 8 * NB * DM; idx += GT) {
            const int c = idx & (DM - 1), bb = (idx >> 10) & 7, j = idx >> 13, lj = j >> 1, wh = j & 1;
            const float* ml = mod + (size_t)(lj * 8 + bb) * 6144;
            const float gg = ml[(wh ? 5120 : 2048) + c], ps = ml[(wh ? 4096 : 1024) + c], ph = ml[(wh ? 3072 : 0) + c];
            const float lg = (wh ? ka->in[29] : ka->in[24])[lj * DM + c], lb = (wh ? ka->in[30] : ka->in[25])[lj * DM + c];
            float hs = 0.f, hh = 0.f;
            if (!wh) { hs = ml[4096 + c]; hh = ml[3072 + c]; }
            else if (lj + 1 < DEPTH) { const float* mn = mod + (size_t)((lj + 1) * 8 + bb) * 6144; hs = mn[1024 + c]; hh = mn[c]; }
            const float pa = ALPHA / (1.0f + ps);
            float* t = (float*)(ws + WS_LNT) + (size_t)(j * 8 + bb) * 5120 + c;
            t[0] = 1.0f + gg; t[1024] = pa; t[2048] = ph * pa; t[3072] = lg * (1.0f + hs); t[4096] = lb * (1.0f + hs) + hh;
        }
        for (size_t idx0 = gtid; idx0 < (size_t)MTOK * DM / 8; idx0 += (size_t)4 * GT) {
            f32x4 xa[4], xb[4];
#pragma unroll
            for (int uu = 0; uu < 4; ++uu) { const size_t e = (idx0 + (size_t)uu * GT) * 8; xa[uu] = *(const f32x4*)(ka->in[0] + e); xb[uu] = *(const f32x4*)(ka->in[0] + e + 4); }
#pragma unroll
            for (int uu = 0; uu < 4; ++uu) {
                const size_t e = (idx0 + (size_t)uu * GT) * 8; const int col = (int)(e & (DM - 1)); const int b = (int)(e >> 23);
                const float* mb = mod + (size_t)b * 6144;
                const f32x4 sh0 = *(const f32x4*)(mb + col), sh1 = *(const f32x4*)(mb + col + 4), sc0 = *(const f32x4*)(mb + 1024 + col), sc1 = *(const f32x4*)(mb + 1024 + col + 4);
                const f32x4 h0 = xa[uu] * (sc0 + 1.0f) + sh0, h1 = xb[uu] * (sc1 + 1.0f) + sh1;
                u32x4 w; w.x = cvt_pk_bf16(h0[0], h0[1]); w.y = cvt_pk_bf16(h0[2], h0[3]); w.z = cvt_pk_bf16(h1[0], h1[1]); w.w = cvt_pk_bf16(h1[2], h1[3]);
                *(u32x4*)(hmod + e) = w;
            }
        }
    }
    grid_bar(wave, smem);
    { PH_PTRS0
    for (int idx = gtid; idx < DEPTH * 16 * 32 * 16 * 32; idx += GT) {
        const int s = idx & 31, h = (idx >> 5) & 15, t = (idx >> 9) & 31, lg = idx >> 14;
        bf16_t* dst = btout + ((size_t)(lg * 512 + t * 16 + h) * KSSM + s * 16);
        float v[16];
        if (s <= t) { const float* kp = Kk + ((size_t)(lg * 32 + (t - s)) * 16 + h) * 16; const float dd = (s == t) ? ka->in[20][lg * 16 + h] : 0.f;
#pragma unroll
            for (int hp = 0; hp < 16; ++hp) v[hp] = kp[hp] + (hp == h ? dd : 0.f); }
        else {
#pragma unroll
            for (int hp = 0; hp < 16; ++hp) v[hp] = 0.f;
        }
        u32x4 o0, o1; o0.x = cvt_pk_bf16(v[0], v[1]); o0.y = cvt_pk_bf16(v[2], v[3]); o0.z = cvt_pk_bf16(v[4], v[5]); o0.w = cvt_pk_bf16(v[6], v[7]);
        o1.x = cvt_pk_bf16(v[8], v[9]); o1.y = cvt_pk_bf16(v[10], v[11]); o1.z = cvt_pk_bf16(v[12], v[13]); o1.w = cvt_pk_bf16(v[14], v[15]);
        *(u32x4*)dst = o0; *(u32x4*)(dst + 8) = o1;
    }
    }
    PH_AMP(0);

    for (int l = 0; l < DEPTH; ++l) {
        for (int rep = 0; rep < REP_MIX; ++rep) {
        { PH_T0();
        {
            PH_PTRS
            pg8::Gemm g{hmod, win_t + (size_t)l * INW * DM, DM, DM, DM};
            pg8::StaticOrder S; S.init(MTOK, INW, G, bid);
            pg8::EpiZ E{zmain, apr, ka->in[5] + l * INW};
            pg8::gemm_phase<pg8::EpiZ, pg8::StaticOrder, true>(lds, g, S, E, wave);
        }
        PH_AMP(1); }
        grid_bar(wave, smem);
        { PH_T0();
        {
            PH_PTRS
            int bidl = bid; asm volatile("" : "+s"(bidl));
            if (bidl < 128) {
                const int gq = bidl >> 3;
                {
                    pg8::Gemm g{apr, w1m + (size_t)l * 4096 * 512, 512, KSSM, 512};
                    pg8::OneUnit S{bidl, gq, true};
                    pg8::EpiStates E{Sst};
                    pg8::gemm_phase<pg8::EpiStates, pg8::OneUnit, true>(lds, g, S, E, wave);
                }
                asm volatile("s_waitcnt vmcnt(0)" ::: "memory");
                __syncthreads();
                {
                    int wvl = wave; asm volatile("" : "+s"(wvl));
                    const int ln = fresh_lane(); const int rowbase = bidl * NCH + wvl * 32;
                    const f32x2 mult = pw[((l * 16 + gq) * 64 + ln) * 33 + 32];
                    f32x2 sv[32];
#pragma unroll
                    for (int j = 0; j < 32; ++j) sv[j] = *(const f32x2*)(Sst + (size_t)(rowbase + j) * 128 + 2 * ln);
                    float er = 0.f, ei = 0.f;
#pragma unroll
                    for (int j = 0; j < 32; ++j) { const float nr = mult.x * er - mult.y * ei + sv[j].x, ni = mult.x * ei + mult.y * er + sv[j].y; er = nr; ei = ni; }
                    f32x2* ex = (f32x2*)(smem + 131072);
                    ex[wvl * 64 + ln] = (f32x2){er, ei};
                    float mr = mult.x, mi = mult.y;
#pragma unroll
                    for (int q = 0; q < 5; ++q) { const float nr = mr * mr - mi * mi, ni = 2.0f * mr * mi; mr = nr; mi = ni; }
                    __syncthreads();
                    float xr = 0.f, xi = 0.f;
                    for (int w2 = 0; w2 < wvl; ++w2) { const f32x2 e = ex[w2 * 64 + ln]; const float nr = mr * xr - mi * xi + e.x, ni = mr * xi + mi * xr + e.y; xr = nr; xi = ni; }
#pragma unroll
                    for (int j = 0; j < 32; ++j) {
                        *(unsigned*)(apr + (size_t)(rowbase + j) * KSSM + 512 + 2 * ln) = cvt_pk_bf16(xr, xi);
                        const float nr = mult.x * xr - mult.y * xi + sv[j].x, ni = mult.x * xi + mult.y * xr + sv[j].y; xr = nr; xi = ni;
                    }
                }
                asm volatile("s_waitcnt vmcnt(0)" ::: "memory");
                __syncthreads();
                {
                    pg8::Gemm g{apr, btout + (size_t)l * 8192 * KSSM, KSSM, KSSM, KSSM};
                    pg8::PairOrder S{bidl, gq * 2};
                    pg8::EpiSsmOut E{yg};
                    pg8::gemm_phase<pg8::EpiSsmOut, pg8::PairOrder, true>(lds, g, S, E, wave);
                }
                __syncthreads();
            }
            const int it0 = bidl < 128 ? bidl * 5 : 640 + (bidl - 128) * 11, it1 = it0 + (bidl < 128 ? 5 : 11);
            mixers_run(it0, it1, zmain, ymix, ka->in[6] + l * 768, ka->in[9] + l * 7936,
                       ka->in[10] + l * 256, ka->in[11] + l * 256, ka->in[12] + l * 256, smem, wave);
        }
        PH_AMP(2); }
        grid_bar(wave, smem);
        { PH_T0();
        {
            PH_PTRS
            pg8::Gemm g{yg, wglu_t + (size_t)l * 65536, 256, 256, 256};
            pg8::StaticOrder S; S.init(MTOK, 256, G, bid);
            pg8::EpiGlu E{yg, ymix, ka->in[22] + l * 256};
            pg8::gemm_phase<pg8::EpiGlu, pg8::StaticOrder, true>(lds, g, S, E, wave);
        }
        PH_AMP(4); }
        grid_bar(wave, smem);
        }
        { PH_T0();
        {
            PH_PTRS
            pg8::Gemm g{ymix, wo_t + (size_t)l * DM * DM, DM, DM, DM};
            pg8::RoundOrder S{bid & 7, bid >> 3};
            pg8::EpiLn E{(float*)nullptr, hmod, (const float*)(ws + WS_LNT) + (size_t)(2 * l) * 8 * 5120,
                         (unsigned long long*)(ws + WS_XCH), ctl + CW_TMO, (unsigned)(2 * l) & 7u, lds + 131072};
            pg8::gemm_phase<pg8::EpiLn, pg8::RoundOrder, true>(lds, g, S, E, wave);
        }
        PH_AMP(5); }
        grid_bar(wave, smem);
        { PH_T0();
        for (int rep = 0; rep < REP_P6; ++rep) {
            PH_PTRS
            pg8::Gemm g{hmod, wgu_t + (size_t)l * 2 * FF * DM, DM, DM, DM};
            pg8::StaticOrder S; S.init(MTOK, 2 * FF, G, bid);
            pg8::EpiSwiGlu E{hid};
            pg8::gemm_phase<pg8::EpiSwiGlu, pg8::StaticOrder, true>(lds, g, S, E, wave);
        }
        PH_AMP(6); }
        grid_bar(wave, smem);
        { PH_T0();
        {
            PH_PTRS
            const float* modn = mod + (size_t)(l + 1 < DEPTH ? l + 1 : l) * 8 * 6144;
            pg8::Gemm g{hid, wdn_t + (size_t)l * DM * FF, FF, FF, FF};
            pg8::RoundOrder S{bid & 7, bid >> 3};
            pg8::EpiLn E{(l + 1 < DEPTH) ? (float*)nullptr : xres, hmod, (const float*)(ws + WS_LNT) + (size_t)(2 * l + 1) * 8 * 5120,
                         (unsigned long long*)(ws + WS_XCH), ctl + CW_TMO, (unsigned)(2 * l + 1) & 7u, lds + 131072};
            pg8::gemm_phase<pg8::EpiLn, pg8::RoundOrder, true>(lds, g, S, E, wave);
        }
        PH_AMP(7); }
        grid_bar(wave, smem);
    }
}

extern "C" void kernel_launch(void* const* d_in, const int* in_sizes, int n_in, void* d_out, int out_size, void* d_ws, size_t ws_size, hipStream_t stream) {
    static int ready = 0;
    if (ready == 0) {
        ready = 1;
        if (n_in != 31 || out_size != MTOK * DM || ws_size < WS_END) { fprintf(stderr, "kernel_launch: unexpected shapes (n_in %d, out %d, ws %zu)\n", n_in, out_size, ws_size); ready = -1; }
        else if (hipFuncSetAttribute((const void*)trunk_fwd, hipFuncAttributeMaxDynamicSharedMemorySize, LDS_BYTES) != hipSuccess) { fprintf(stderr, "kernel_launch: hipFuncSetAttribute failed\n"); ready = -1; }
        else { int per_cu = 0; if (hipOccupancyMaxActiveBlocksPerMultiprocessor(&per_cu, (const void*)trunk_fwd, NTHREADS, LDS_BYTES) != hipSuccess || per_cu < 1) fprintf(stderr, "kernel_launch: occupancy query reports %d\n", per_cu); (void)hipGetLastError(); }
    }
    if (ready < 0) return;
    (void)hipMemsetAsync((char*)d_ws + WS_CTL, 0, CTL_BYTES, stream);
    Args a{};
    for (int i = 0; i < 31; ++i) a.in[i] = (const float*)d_in[i];
    a.out = (float*)d_out; a.ws = (unsigned char*)d_ws;
    void* kargs[] = {&a};
    hipError_t e = hipLaunchCooperativeKernel((const void*)trunk_fwd, dim3(GRID), dim3(NTHREADS), kargs, LDS_BYTES, stream);
    if (e != hipSuccess) fprintf(stderr, "kernel_launch: cooperative launch failed: %s\n", hipGetErrorString(e));
}
```

```cpp
#include <hip/hip_runtime.h>
#include <hip/hip_cooperative_groups.h>
#include <cstdio>
#include <cstdint>
namespace cg = cooperative_groups;

#define LAS __attribute__((address_space(3)))
typedef unsigned short bf16_t;
typedef short bf16x8 __attribute__((ext_vector_type(8)));
typedef float f32x4 __attribute__((ext_vector_type(4)));
typedef float f32x2 __attribute__((ext_vector_type(2)));
typedef unsigned u32x4 __attribute__((ext_vector_type(4)));
typedef unsigned u32x2 __attribute__((ext_vector_type(2)));

constexpr int DM = 1024, NB = 8, SEQ = 8192, MTOK = NB * SEQ, DEPTH = 4, FF = 2816, INW = 1792, ZW = 1024;
constexpr int CT = 32, NCH = SEQ / CT, NBC = NB * NCH, KSSM = 640;
constexpr float ALPHA = 1.681792830507429f;
constexpr float LN_EPS = 1e-5f;
constexpr int NTHREADS = 512, GRID = 256;
constexpr unsigned AMP_MASK = 0u;
constexpr int REP_MIX = 1, REP_P6 = 1;

constexpr size_t MiB = 1u << 20;
constexpr size_t WS_CTL = 0, CTL_BYTES = 1 * MiB;
constexpr size_t WS_XCH = 1 * MiB;
constexpr size_t WS_MOD = 3 * MiB;
constexpr size_t WS_PW = 4 * MiB;
constexpr size_t WS_BBAR = 6 * MiB;
constexpr size_t WS_KK = 7 * MiB;
constexpr size_t WS_WIN = 10 * MiB;
constexpr size_t WS_WO = 24 * MiB;
constexpr size_t WS_WGU = 32 * MiB;
constexpr size_t WS_WDN = 76 * MiB;
constexpr size_t WS_WGLU = 98 * MiB;
constexpr size_t WS_BTOUT = 100 * MiB;
constexpr size_t WS_W1 = 140 * MiB;
constexpr size_t WS_HMOD = 156 * MiB;
constexpr size_t WS_ZMAIN = 284 * MiB;
constexpr size_t WS_APR = 476 * MiB;
constexpr size_t WS_S = 516 * MiB;
constexpr size_t WS_YG = 532 * MiB;
constexpr size_t WS_YMIX = 564 * MiB;
constexpr size_t WS_HID = 284 * MiB;
constexpr size_t WS_LNT = 692 * MiB;
constexpr size_t WS_END = 694 * MiB;
constexpr int CW_TMO = 0, CW_CNT = 1024, CW_XB = 32768;

constexpr int LDS_BYTES = 147456;

__device__ __forceinline__ unsigned cvt_pk_bf16(float lo, float hi) { unsigned r; asm volatile("v_cvt_pk_bf16_f32 %0, %1, %2" : "=v"(r) : "v"(lo), "v"(hi)); return r; }
__device__ __forceinline__ void ld8(const bf16_t* p, float (&f)[8]) {
    const u32x4 w = *(const u32x4*)p;
    f[0] = __uint_as_float(w.x << 16); f[1] = __uint_as_float(w.x & 0xffff0000u);
    f[2] = __uint_as_float(w.y << 16); f[3] = __uint_as_float(w.y & 0xffff0000u);
    f[4] = __uint_as_float(w.z << 16); f[5] = __uint_as_float(w.z & 0xffff0000u);
    f[6] = __uint_as_float(w.w << 16); f[7] = __uint_as_float(w.w & 0xffff0000u);
}
__device__ __forceinline__ void st8(bf16_t* p, const float (&f)[8]) {
    u32x4 w; w.x = cvt_pk_bf16(f[0], f[1]); w.y = cvt_pk_bf16(f[2], f[3]); w.z = cvt_pk_bf16(f[4], f[5]); w.w = cvt_pk_bf16(f[6], f[7]);
    *(u32x4*)p = w;
}
__device__ __forceinline__ float sigmoidf_(float a) { return __builtin_amdgcn_rcpf(1.0f + __expf(-a)); }
__device__ __forceinline__ float siluf_(float a) { return a * sigmoidf_(a); }
__device__ __forceinline__ float gelu_tanh_(float v) { const float u = 0.7978845608028654f * (v + 0.044715f * v * v * v); return v * sigmoidf_(2.0f * u); }
__device__ __forceinline__ int fresh_lane() { int l; asm volatile("v_mbcnt_lo_u32_b32 %0, -1, 0\n\tv_mbcnt_hi_u32_b32 %0, -1, %0" : "=v"(l)); return l; }
__device__ __forceinline__ float shfl_xor_l(float v, int o, int lane) { return __int_as_float(__builtin_amdgcn_ds_bpermute((lane ^ o) << 2, __float_as_int(v))); }
__device__ __forceinline__ float wave_sum(float v, int lane) {
#pragma unroll
    for (int o = 1; o < 64; o <<= 1) v += shfl_xor_l(v, o, lane);
    return v;
}

namespace pg8 {
constexpr int BM = 256, BK = 64, HALF = 128, HTB = HALF * BK * 2, STAGE_BYTES = 8 * HTB, NXCD = 8, WGM = 4;
__host__ __device__ __forceinline__ int lds_byte(int r, int c) { const int st = (r >> 4) * 2 + (c >> 5), rr = r & 15, cc = c & 31, ob = rr * 64 + cc * 2; return st * 1024 + (ob ^ (((ob >> 9) & 1) << 5)); }
__host__ __device__ __forceinline__ void stage_rc(int b, int& R, int& C) { const int st = b / 1024, sb = b % 1024, swz = sb ^ (((sb >> 9) & 1) << 5); R = (st >> 1) * 16 + swz / 64; C = (st & 1) * 32 + (swz % 64) / 2; }
__host__ __device__ __forceinline__ int perm32(int rho) { const int n = rho >> 4, i = rho & 15; return 8 * (i >> 2) + 4 * n + (i & 3); }

struct Unit { int pm, pn; };
struct Gemm { const bf16_t* A; const bf16_t* Bt; int K, lda, ldb; };

struct StaticOrder {
    int nM, nN, nwg, G, c;
    __device__ void init(int M, int N, int G_, int c_) { nM = M / BM; nN = N / BM; nwg = nM * nN; G = G_; c = c_; }
    __device__ bool next(int i, Unit& u) const {
        const long L = (long)i * G + c; if (L >= nwg) return false;
        int wgid = (int)L; { const int q = nwg / NXCD, r = nwg % NXCD, xcd = wgid % NXCD, off = wgid / NXCD; wgid = (xcd < r ? xcd * (q + 1) : r * (q + 1) + (xcd - r) * q) + off; }
        const int nig = WGM * nN, gid = wgid / nig, fm = gid * WGM;
        u.pm = fm + ((wgid % nig) % WGM); u.pn = (wgid % nig) / WGM; return true;
    }
};
struct RoundOrder {
    int xcd, slot;
    __device__ bool next(int i, Unit& u) const { if (i >= 4) return false; u.pm = i * 64 + xcd * 8 + (slot >> 2); u.pn = slot & 3; return true; }
};
struct PairOrder {
    int pm, pn0;
    __device__ bool next(int i, Unit& u) const { if (i >= 2) return false; u.pm = pm; u.pn = pn0 + i; return true; }
};
struct OneUnit {
    int pm, pn; bool valid;
    __device__ bool next(int i, Unit& u) const { if (i != 0 || !valid) return false; u.pm = pm; u.pn = pn; return true; }
};

template <class Epi, class Sched, bool ALIGN_EPI>
__device__ __forceinline__ void gemm_phase(LAS unsigned char* lds, const Gemm g, const Sched& S, const Epi& E, int wid) {
    asm volatile("" : "+s"(wid));
    const int wr = wid >> 2, wc = wid & 3; int fr = 0, fq = 0;
    const int K = g.K, nt = K / BK;
    unsigned voffA[2], voffB[2]; int aoff, boff;
#define PG8_LANE_CONSTS() do { const int lane_ = fresh_lane(), tid_ = wid * 64 + lane_; fr = lane_ & 15; fq = lane_ >> 4; \
        _Pragma("unroll") for (int i = 0; i < 2; ++i) { int R, C; stage_rc(tid_ * 16 + i * 8192, R, C); const int Rb = Epi::PERM ? ((R & ~31) + perm32(R & 31)) : R; \
            voffA[i] = (unsigned)(R * g.lda + C) * 2u; voffB[i] = (unsigned)(Rb * g.ldb + C) * 2u; } \
        aoff = lds_byte(wr * 64 + fr, fq * 8); boff = lds_byte(wc * 32 + fr, fq * 8); } while (0)
    PG8_LANE_CONSTS();
    const size_t kstep = (size_t)(BK * 2);
    const size_t hstepA = (size_t)HALF * g.lda * 2, hstepB = (size_t)HALF * g.ldb * 2;
    const size_t tstepA = 2 * hstepA, tstepB = 2 * hstepB;
    const unsigned ldsw = (unsigned)wid * 1024u;
#define PG8_SA(b, h) (((b) * 2 + (h)) * HTB)
#define PG8_SB(b, h) ((4 + (b) * 2 + (h)) * HTB)
#define PG8_STAGE(bufoff, gbase, voff) do { _Pragma("unroll") for (int _i = 0; _i < 2; ++_i) \
        __builtin_amdgcn_global_load_lds((const unsigned*)((const char*)(gbase) + (voff)[_i]), (LAS unsigned*)(lds + (bufoff) + ldsw + _i * 8192), 16, 0, 0); } while (0)
#define PG8_LDA(dst, b, h) do { _Pragma("unroll") for (int m = 0; m < 4; ++m) _Pragma("unroll") for (int k = 0; k < 2; ++k) dst[m][k] = *(const LAS bf16x8*)(lds + PG8_SA(b, h) + aoff + m * 2048 + k * 1024); } while (0)
#define PG8_LDB(dst, b, h) do { _Pragma("unroll") for (int n = 0; n < 2; ++n) _Pragma("unroll") for (int k = 0; k < 2; ++k) dst[n][k] = *(const LAS bf16x8*)(lds + PG8_SB(b, h) + boff + n * 2048 + k * 1024); } while (0)
#define PG8_MMA(ai, bj, At, Bt) do { __builtin_amdgcn_s_setprio(1); _Pragma("unroll") for (int m = 0; m < 4; ++m) _Pragma("unroll") for (int n = 0; n < 2; ++n) _Pragma("unroll") for (int k = 0; k < 2; ++k) \
        acc[ai][bj][m][n] = __builtin_amdgcn_mfma_f32_16x16x32_bf16(Bt[n][k], At[m][k], acc[ai][bj][m][n], 0, 0, 0); __builtin_amdgcn_s_setprio(0); } while (0)
#define PG8_WAIT_V(n) asm volatile("s_waitcnt vmcnt(" #n ")" ::: "memory")
#define PG8_WAIT_L(n) asm volatile("s_waitcnt lgkmcnt(" #n ")" ::: "memory")
#define PG8_BAR __builtin_amdgcn_s_barrier()
#define PG8_SCHED __builtin_amdgcn_sched_barrier(0)
    Unit cur, nxt; int ui = 0;
    if (!S.next(0, cur)) return;
    f32x4 acc[2][2][4][2];
#pragma unroll
    for (int a = 0; a < 2; ++a)
#pragma unroll
        for (int b = 0; b < 2; ++b)
#pragma unroll
            for (int m = 0; m < 4; ++m)
#pragma unroll
                for (int n = 0; n < 2; ++n) acc[a][b][m][n] = (f32x4){0.f, 0.f, 0.f, 0.f};
    bf16x8 At[4][2], B0[2][2], B1[2][2];
    const char* cA = (const char*)g.A + (size_t)cur.pm * tstepA; const char* cB = (const char*)g.Bt + (size_t)cur.pn * tstepB;
    PG8_STAGE(PG8_SB(0, 0), cB, voffB); PG8_STAGE(PG8_SB(0, 1), cB + hstepB, voffB); PG8_STAGE(PG8_SA(0, 0), cA, voffA); PG8_STAGE(PG8_SA(0, 1), cA + hstepA, voffA);
    if (wr == 1) PG8_BAR;
    PG8_WAIT_V(2); PG8_BAR;
    PG8_STAGE(PG8_SB(1, 0), cB + kstep, voffB); PG8_STAGE(PG8_SA(1, 0), cA + kstep, voffA); PG8_STAGE(PG8_SB(1, 1), cB + hstepB + kstep, voffB);
    PG8_WAIT_V(6); PG8_BAR;
    for (;;) {
        PG8_LANE_CONSTS();
        const bool has_next = S.next(ui + 1, nxt);
        const char* nA = has_next ? (const char*)g.A + (size_t)nxt.pm * tstepA : cA; const char* nB = has_next ? (const char*)g.Bt + (size_t)nxt.pn * tstepB : cB;
        for (int t = 0; t < nt; t += 2) {
            const bool last = (t == nt - 2);
            const char* a1 = cA + (size_t)(t + 1) * kstep;
            const char* a2 = last ? nA : cA + (size_t)(t + 2) * kstep; const char* b2 = last ? nB : cB + (size_t)(t + 2) * kstep;
            const char* a3 = a2 + kstep; const char* b3 = b2 + kstep;
            PG8_LDB(B0, 0, 0); PG8_LDB(B1, 0, 1); PG8_SCHED; PG8_LDA(At, 0, 0); PG8_STAGE(PG8_SA(1, 1), a1 + hstepA, voffA);
            PG8_WAIT_V(8); PG8_WAIT_L(0); PG8_BAR; PG8_MMA(0, 0, At, B0); PG8_MMA(0, 1, At, B1); PG8_BAR; PG8_SCHED;
            PG8_LDA(At, 0, 1); PG8_STAGE(PG8_SB(0, 0), b2, voffB); PG8_STAGE(PG8_SB(0, 1), b2 + hstepB, voffB); PG8_STAGE(PG8_SA(0, 0), a2, voffA);
            PG8_WAIT_V(8); PG8_WAIT_L(0); PG8_BAR; PG8_MMA(1, 0, At, B0); PG8_MMA(1, 1, At, B1); PG8_BAR; PG8_SCHED;
            PG8_LDB(B0, 1, 0); PG8_LDB(B1, 1, 1); PG8_SCHED; PG8_LDA(At, 1, 0); PG8_STAGE(PG8_SA(0, 1), a2 + hstepA, voffA);
            PG8_WAIT_V(8); PG8_WAIT_L(0); PG8_BAR; PG8_MMA(0, 0, At, B0); PG8_MMA(0, 1, At, B1); PG8_BAR; PG8_SCHED;
            PG8_LDA(At, 1, 1); PG8_STAGE(PG8_SB(1, 0), b3, voffB); PG8_STAGE(PG8_SB(1, 1), b3 + hstepB, voffB); PG8_STAGE(PG8_SA(1, 0), a3, voffA);
            PG8_WAIT_V(8); PG8_WAIT_L(0); PG8_BAR; PG8_MMA(1, 0, At, B0); PG8_MMA(1, 1, At, B1); PG8_BAR; PG8_SCHED;
        }
        if constexpr (ALIGN_EPI) { if (wr == 0) PG8_BAR; }
        if constexpr (!Epi::AFTER_DRAIN) { E(acc, cur, wr, wc, fr, fq); }
        if (!has_next) break;
#pragma unroll
        for (int a = 0; a < 2; ++a)
#pragma unroll
            for (int b = 0; b < 2; ++b)
#pragma unroll
                for (int m = 0; m < 4; ++m)
#pragma unroll
                    for (int n = 0; n < 2; ++n) acc[a][b][m][n] = (f32x4){0.f, 0.f, 0.f, 0.f};
        cur = nxt; cA = nA; cB = nB; ++ui;
        if constexpr (ALIGN_EPI) { if (wr == 1) PG8_BAR; }
    }
    PG8_WAIT_V(0);
    if constexpr (!ALIGN_EPI) { if (wr == 0) PG8_BAR; }
    PG8_BAR;
    static_assert(!Epi::AFTER_DRAIN, "all epilogues run inline");
#undef PG8_LANE_CONSTS
#undef PG8_SA
#undef PG8_SB
#undef PG8_STAGE
#undef PG8_LDA
#undef PG8_LDB
#undef PG8_MMA
#undef PG8_WAIT_V
#undef PG8_WAIT_L
#undef PG8_BAR
#undef PG8_SCHED
}


struct EpiZ {
    static constexpr bool PERM = true, AFTER_DRAIN = false;
    bf16_t* zmain; bf16_t* apr; const float* bias;
    __device__ __forceinline__ void operator()(const f32x4 (&acc)[2][2][4][2], const Unit& u, int wr, int wc, int fr_, int fq_) const {
        const int ln_ = fresh_lane(), fr = ln_ & 15, fq = ln_ >> 4;
        int row0 = u.pm * BM + wr * 64 + fr, cl = wc * 32 + 8 * fq; asm volatile("" : "+v"(row0));
        const int pn = u.pn;
        if (pn == 2 || pn == 3 || pn == 6) {
            const int sbase = pn == 2 ? 256 : (pn == 3 ? 768 : 1536), obase = pn == 2 ? 256 : 512;
#pragma unroll
            for (int bj = 0; bj < 2; ++bj) {
                const int c = bj * HALF + cl;
                const f32x4 b0 = *(const f32x4*)(bias + sbase + c), b1 = *(const f32x4*)(bias + sbase + c + 4);
#pragma unroll
                for (int ai = 0; ai < 2; ++ai)
#pragma unroll
                    for (int m = 0; m < 4; ++m) {
                        const int row = row0 + ai * HALF + m * 16;
                        const f32x4 v0 = acc[ai][bj][m][0] + b0, v1 = acc[ai][bj][m][1] + b1;
                        u32x4 w; w.x = cvt_pk_bf16(v0[0], v0[1]); w.y = cvt_pk_bf16(v0[2], v0[3]); w.z = cvt_pk_bf16(v1[0], v1[1]); w.w = cvt_pk_bf16(v1[2], v1[3]);
                        if (pn != 6) *(u32x4*)(zmain + (size_t)row * ZW + obase + c) = w;
                        else { const int gq = c >> 4, h0 = c & 15;
                            *(u32x4*)(apr + ((size_t)(gq * NBC + (row >> 5)) * KSSM + (row & 31) * 16 + h0)) = w; }
                    }
            }
        } else {
            const bool glu = pn >= 4; const int hc = (pn & 1) * HALF + cl;
            const int sa = glu ? 1024 : 0, sb = glu ? 1280 : 512, obase = glu ? 768 : 0;
            const f32x4 a0 = *(const f32x4*)(bias + sa + hc), a1 = *(const f32x4*)(bias + sa + hc + 4), c0 = *(const f32x4*)(bias + sb + hc), c1 = *(const f32x4*)(bias + sb + hc + 4);
#pragma unroll
            for (int ai = 0; ai < 2; ++ai)
#pragma unroll
                for (int m = 0; m < 4; ++m) {
                    const int row = row0 + ai * HALF + m * 16;
                    const f32x4 x0 = acc[ai][0][m][0] + a0, x1 = acc[ai][0][m][1] + a1, y0 = acc[ai][1][m][0] + c0, y1 = acc[ai][1][m][1] + c1;
                    float o[8];
                    if (glu) { o[0] = x0[0] * sigmoidf_(y0[0]); o[1] = x0[1] * sigmoidf_(y0[1]); o[2] = x0[2] * sigmoidf_(y0[2]); o[3] = x0[3] * sigmoidf_(y0[3]);
                               o[4] = x1[0] * sigmoidf_(y1[0]); o[5] = x1[1] * sigmoidf_(y1[1]); o[6] = x1[2] * sigmoidf_(y1[2]); o[7] = x1[3] * sigmoidf_(y1[3]); }
                    else { o[0] = x0[0] * y0[0]; o[1] = x0[1] * y0[1]; o[2] = x0[2] * y0[2]; o[3] = x0[3] * y0[3]; o[4] = x1[0] * y1[0]; o[5] = x1[1] * y1[1]; o[6] = x1[2] * y1[2]; o[7] = x1[3] * y1[3]; }
                    st8(zmain + (size_t)row * ZW + obase + hc, o);
                }
        }
    }
};
struct EpiStates {
    static constexpr bool PERM = false, AFTER_DRAIN = false;
    float* S;
    __device__ __forceinline__ void operator()(const f32x4 (&acc)[2][2][4][2], const Unit& u, int wr, int wc, int fr_, int fq_) const {
        const int ln_ = fresh_lane(), fr = ln_ & 15, fq = ln_ >> 4;
        int row0 = u.pm * BM + wr * 64 + fr, c0 = wc * 32 + 4 * fq; asm volatile("" : "+v"(row0));
#pragma unroll
        for (int ai = 0; ai < 2; ++ai)
#pragma unroll
            for (int m = 0; m < 4; ++m)
#pragma unroll
                for (int n = 0; n < 2; ++n) *(f32x4*)(S + (size_t)(row0 + ai * HALF + m * 16) * 128 + c0 + n * 16) = acc[ai][0][m][n];
    }
};
struct EpiSsmOut {
    static constexpr bool PERM = true, AFTER_DRAIN = false;
    bf16_t* yg;
    __device__ __forceinline__ void operator()(const f32x4 (&acc)[2][2][4][2], const Unit& u, int wr, int wc, int fr_, int fq_) const {
        const int ln_ = fresh_lane(), fr = ln_ & 15, fq = ln_ >> 4;
        const int gq = u.pn >> 1; int R0 = u.pm * BM + wr * 64 + fr; asm volatile("" : "+v"(R0));
#pragma unroll
        for (int bj = 0; bj < 2; ++bj) {
            const int lc = (u.pn & 1) * 256 + bj * HALF + wc * 32 + 8 * fq, t = lc >> 4, h0 = lc & 15;
#pragma unroll
            for (int ai = 0; ai < 2; ++ai)
#pragma unroll
                for (int m = 0; m < 4; ++m) {
                    const int R = R0 + ai * HALF + m * 16, bc = R & (NBC - 1);
                    const f32x4 v0 = acc[ai][bj][m][0], v1 = acc[ai][bj][m][1];
                    u32x4 w; w.x = cvt_pk_bf16(gelu_tanh_(v0[0]), gelu_tanh_(v0[1])); w.y = cvt_pk_bf16(gelu_tanh_(v0[2]), gelu_tanh_(v0[3]));
                    w.z = cvt_pk_bf16(gelu_tanh_(v1[0]), gelu_tanh_(v1[1])); w.w = cvt_pk_bf16(gelu_tanh_(v1[2]), gelu_tanh_(v1[3]));
                    *(u32x4*)(yg + (size_t)(bc * CT + t) * 256 + gq * 16 + h0) = w;
                }
        }
    }
};
struct EpiGlu {
    static constexpr bool PERM = true, AFTER_DRAIN = false;
    const bf16_t* yg; bf16_t* ymix; const float* bias;
    __device__ __forceinline__ void operator()(const f32x4 (&acc)[2][2][4][2], const Unit& u, int wr, int wc, int fr_, int fq_) const {
        const int ln_ = fresh_lane(), fr = ln_ & 15, fq = ln_ >> 4;
        int row0 = u.pm * BM + wr * 64 + fr, cl = wc * 32 + 8 * fq; asm volatile("" : "+v"(row0));
#pragma unroll
        for (int bj = 0; bj < 2; ++bj) {
            const int c = bj * HALF + cl;
            const f32x4 b0 = *(const f32x4*)(bias + c), b1 = *(const f32x4*)(bias + c + 4);
            u32x4 yv[2][4];
#pragma unroll
            for (int ai = 0; ai < 2; ++ai)
#pragma unroll
                for (int m = 0; m < 4; ++m) yv[ai][m] = *(const u32x4*)(yg + (size_t)(row0 + ai * HALF + m * 16) * 256 + c);
#pragma unroll
            for (int ai = 0; ai < 2; ++ai)
#pragma unroll
                for (int m = 0; m < 4; ++m) {
                    const int row = row0 + ai * HALF + m * 16; const u32x4 w = yv[ai][m];
                    const f32x4 v0 = acc[ai][bj][m][0] + b0, v1 = acc[ai][bj][m][1] + b1;
                    float o[8];
                    o[0] = __uint_as_float(w.x << 16) * sigmoidf_(v0[0]); o[1] = __uint_as_float(w.x & 0xffff0000u) * sigmoidf_(v0[1]);
                    o[2] = __uint_as_float(w.y << 16) * sigmoidf_(v0[2]); o[3] = __uint_as_float(w.y & 0xffff0000u) * sigmoidf_(v0[3]);
                    o[4] = __uint_as_float(w.z << 16) * sigmoidf_(v1[0]); o[5] = __uint_as_float(w.z & 0xffff0000u) * sigmoidf_(v1[1]);
                    o[6] = __uint_as_float(w.w << 16) * sigmoidf_(v1[2]); o[7] = __uint_as_float(w.w & 0xffff0000u) * sigmoidf_(v1[3]);
                    st8(ymix + (size_t)row * DM + 768 + c, o);
                }
            asm volatile("" ::: "memory");
        }
    }
};
struct EpiSwiGlu {
    static constexpr bool PERM = true, AFTER_DRAIN = false;
    bf16_t* hid;
    __device__ __forceinline__ void operator()(const f32x4 (&acc)[2][2][4][2], const Unit& u, int wr, int wc, int fr_, int fq_) const {
        const int ln_ = fresh_lane(), fr = ln_ & 15, fq = ln_ >> 4;
        int row0 = u.pm * BM + wr * 64 + fr, c = u.pn * HALF + wc * 32 + 8 * fq; asm volatile("" : "+v"(row0));
#pragma unroll
        for (int ai = 0; ai < 2; ++ai)
#pragma unroll
            for (int m = 0; m < 4; ++m) {
                const int row = row0 + ai * HALF + m * 16;
                const f32x4 g0 = acc[ai][0][m][0], g1 = acc[ai][0][m][1], u0 = acc[ai][1][m][0], u1 = acc[ai][1][m][1];
                const f32x4 t0 = g0 * (-1.4426950408889634f), t1 = g1 * (-1.4426950408889634f);
                const f32x4 d0 = (f32x4){__builtin_amdgcn_exp2f(t0[0]), __builtin_amdgcn_exp2f(t0[1]), __builtin_amdgcn_exp2f(t0[2]), __builtin_amdgcn_exp2f(t0[3])} + 1.0f;
                const f32x4 d1 = (f32x4){__builtin_amdgcn_exp2f(t1[0]), __builtin_amdgcn_exp2f(t1[1]), __builtin_amdgcn_exp2f(t1[2]), __builtin_amdgcn_exp2f(t1[3])} + 1.0f;
                const f32x4 r0 = (f32x4){__builtin_amdgcn_rcpf(d0[0]), __builtin_amdgcn_rcpf(d0[1]), __builtin_amdgcn_rcpf(d0[2]), __builtin_amdgcn_rcpf(d0[3])};
                const f32x4 r1 = (f32x4){__builtin_amdgcn_rcpf(d1[0]), __builtin_amdgcn_rcpf(d1[1]), __builtin_amdgcn_rcpf(d1[2]), __builtin_amdgcn_rcpf(d1[3])};
                const f32x4 o0 = (g0 * r0) * u0, o1 = (g1 * r1) * u1;
                u32x4 w; w.x = cvt_pk_bf16(o0[0], o0[1]); w.y = cvt_pk_bf16(o0[2], o0[3]); w.z = cvt_pk_bf16(o1[0], o1[1]); w.w = cvt_pk_bf16(o1[2], o1[3]);
                __builtin_nontemporal_store(w, (u32x4*)(hid + (size_t)row * FF + c));
            }
    }
};
struct EpiLn {
    static constexpr bool PERM = true, AFTER_DRAIN = false;
    float* xout; bf16_t* h; const float* tab;
    unsigned long long* xbuf; unsigned* tmo; unsigned tag; LAS unsigned char* xl;
    __device__ __forceinline__ void operator()(f32x4 (&acc)[2][2][4][2], const Unit& u, int wr, int wc, int fr_, int fq_) const {
        const int wid = wr * 4 + wc; LAS unsigned char* lds = xl;
        const int lane = fresh_lane(), fr = lane & 15, fq = lane >> 4;
        const float* tb = tab + (u.pm >> 5) * 5120;
        const int col0 = u.pn * BM + wc * 32 + 8 * fq;
        int rloc = wr * 64 + fr; asm volatile("" : "+v"(rloc));
#pragma unroll
        for (int bj = 0; bj < 2; ++bj) {
            f32x4 gv[2], pa[2], pb[2]; u32x4 hv[2][4];
            const int colb = col0 + bj * HALF;
#pragma unroll
            for (int n = 0; n < 2; ++n) { gv[n] = *(const f32x4*)(tb + colb + 4 * n); pa[n] = *(const f32x4*)(tb + 1024 + colb + 4 * n); pb[n] = *(const f32x4*)(tb + 2048 + colb + 4 * n); }
#pragma unroll
            for (int ai = 0; ai < 2; ++ai)
#pragma unroll
                for (int m = 0; m < 4; ++m) hv[ai][m] = *(const u32x4*)(h + (size_t)(u.pm * BM + rloc + ai * HALF + m * 16) * DM + colb);
#pragma unroll
            for (int ai = 0; ai < 2; ++ai)
#pragma unroll
                for (int m = 0; m < 4; ++m) {
                    const u32x4 w = hv[ai][m];
                    const f32x4 hx0 = (f32x4){__uint_as_float(w.x << 16), __uint_as_float(w.x & 0xffff0000u), __uint_as_float(w.y << 16), __uint_as_float(w.y & 0xffff0000u)};
                    const f32x4 hx1 = (f32x4){__uint_as_float(w.z << 16), __uint_as_float(w.z & 0xffff0000u), __uint_as_float(w.w << 16), __uint_as_float(w.w & 0xffff0000u)};
                    acc[ai][bj][m][0] = hx0 * pa[0] + (gv[0] * acc[ai][bj][m][0] - pb[0]);
                    acc[ai][bj][m][1] = hx1 * pa[1] + (gv[1] * acc[ai][bj][m][1] - pb[1]);
                    asm volatile("" : "+v"(acc[ai][bj][m][0]), "+v"(acc[ai][bj][m][1]));
                }
            asm volatile("" ::: "memory");
        }
        f32x4 oa[2][2], ob[2][2];
#pragma unroll
        for (int bj = 0; bj < 2; ++bj)
#pragma unroll
            for (int n = 0; n < 2; ++n) {
                const int col = col0 + bj * HALF + 4 * n;
                oa[bj][n] = *(const f32x4*)(tb + 3072 + col); ob[bj][n] = *(const f32x4*)(tb + 4096 + col);
            }
        LAS f32x2* P = (LAS f32x2*)lds;
        LAS f32x2* Sx = (LAS f32x2*)(lds + 8192);
#pragma unroll
        for (int ai = 0; ai < 2; ++ai)
#pragma unroll
            for (int m = 0; m < 4; ++m) {
                f32x4 s4 = (f32x4){0.f, 0.f, 0.f, 0.f}, q4 = s4;
#pragma unroll
                for (int bj = 0; bj < 2; ++bj)
#pragma unroll
                    for (int n = 0; n < 2; ++n) { const f32x4 v = acc[ai][bj][m][n]; s4 += v; q4 += v * v; }
                float s = (s4[0] + s4[1]) + (s4[2] + s4[3]), q = (q4[0] + q4[1]) + (q4[2] + q4[3]);
                s += shfl_xor_l(s, 16, lane); q += shfl_xor_l(q, 16, lane); s += shfl_xor_l(s, 32, lane); q += shfl_xor_l(q, 32, lane);
                if (fq == 0) P[(ai * HALF + rloc + m * 16) * 4 + wc] = (f32x2){s, q};
            }
        asm volatile("s_waitcnt lgkmcnt(0)" ::: "memory"); __builtin_amdgcn_s_barrier(); asm volatile("" ::: "memory");
        const int row = wid * 32 + (lane & 31);
        if (lane < 32) {
            const f32x2 a = P[row * 4 + 0], bq = P[row * 4 + 1], c = P[row * 4 + 2], d = P[row * 4 + 3];
            const float s1 = (a.x + bq.x) + (c.x + d.x), s2 = (a.y + bq.y) + (c.y + d.y);
            unsigned long long* slot = xbuf + (size_t)(u.pm * BM + row) * 4;
            __hip_atomic_store(slot + u.pn, ((unsigned long long)((__float_as_uint(s2) & ~7u) | tag) << 32) | __float_as_uint(s1), __ATOMIC_RELAXED, __HIP_MEMORY_SCOPE_AGENT);
            unsigned long long w0, w1, w2, w3; unsigned sp = 0;
            for (;;) {
                w0 = __hip_atomic_load(slot + 0, __ATOMIC_RELAXED, __HIP_MEMORY_SCOPE_AGENT); w1 = __hip_atomic_load(slot + 1, __ATOMIC_RELAXED, __HIP_MEMORY_SCOPE_AGENT);
                w2 = __hip_atomic_load(slot + 2, __ATOMIC_RELAXED, __HIP_MEMORY_SCOPE_AGENT); w3 = __hip_atomic_load(slot + 3, __ATOMIC_RELAXED, __HIP_MEMORY_SCOPE_AGENT);
                const unsigned t0 = (unsigned)(w0 >> 32) & 7u, t1 = (unsigned)(w1 >> 32) & 7u, t2 = (unsigned)(w2 >> 32) & 7u, t3 = (unsigned)(w3 >> 32) & 7u;
                if (t0 == tag && t1 == tag && t2 == tag && t3 == tag) break;
                if (++sp > (1u << 20)) { __hip_atomic_store(tmo, 1u, __ATOMIC_RELAXED, __HIP_MEMORY_SCOPE_AGENT); break; }
                __builtin_amdgcn_s_sleep(1);
            }
            const float T1 = (__uint_as_float((unsigned)w0) + __uint_as_float((unsigned)w1)) + (__uint_as_float((unsigned)w2) + __uint_as_float((unsigned)w3));
            const float T2 = (__uint_as_float((unsigned)(w0 >> 32) & ~7u) + __uint_as_float((unsigned)(w1 >> 32) & ~7u)) + (__uint_as_float((unsigned)(w2 >> 32) & ~7u) + __uint_as_float((unsigned)(w3 >> 32) & ~7u));
            const float mean = T1 * (1.0f / 1024.0f); float var = T2 * (1.0f / 1024.0f) - mean * mean; var = var > 0.f ? var : 0.f;
            Sx[row] = (f32x2){mean, __builtin_amdgcn_rsqf(var + LN_EPS)};
        }
        asm volatile("s_waitcnt lgkmcnt(0)" ::: "memory"); __builtin_amdgcn_s_barrier(); asm volatile("" ::: "memory");
        asm volatile("" : "+v"(rloc));
#pragma unroll
        for (int bj = 0; bj < 2; ++bj)
#pragma unroll
            for (int ai = 0; ai < 2; ++ai)
#pragma unroll
                for (int m = 0; m < 4; ++m) {
                    const int r = ai * HALF + rloc + m * 16; const f32x2 sr = Sx[r];
                    const size_t off = (size_t)(u.pm * BM + r) * DM + col0 + bj * HALF;
                    const f32x4 o0 = (acc[ai][bj][m][0] - sr.x) * sr.y * oa[bj][0] + ob[bj][0];
                    const f32x4 o1 = (acc[ai][bj][m][1] - sr.x) * sr.y * oa[bj][1] + ob[bj][1];
                    if (xout) { *(f32x4*)(xout + off) = o0; *(f32x4*)(xout + off + 4) = o1; }
                    else { u32x4 w; w.x = cvt_pk_bf16(o0[0], o0[1]); w.y = cvt_pk_bf16(o0[2], o0[3]); w.z = cvt_pk_bf16(o1[0], o1[1]); w.w = cvt_pk_bf16(o1[2], o1[3]); *(u32x4*)(h + off) = w; }
                }
    }
};
}

struct Args { const float* in[31]; float* out; unsigned char* ws; };
#define CAS __attribute__((address_space(4)))
__device__ __forceinline__ const CAS Args* fresh_args() { const CAS Args* p = (const CAS Args*)__builtin_amdgcn_kernarg_segment_ptr(); asm volatile("" : "+s"(p)); return p; }
#define PH_PTRS0 const int l_ = 0; PH_PTRS_(l_)
#define PH_PTRS PH_PTRS_(l)
#define PH_PTRS_(l) \
    const CAS Args* ka = fresh_args(); unsigned char* ws = ka->ws; \
    [[maybe_unused]] unsigned* ctl = (unsigned*)(ws + WS_CTL); [[maybe_unused]] float* mod = (float*)(ws + WS_MOD); \
    [[maybe_unused]] f32x2* pw = (f32x2*)(ws + WS_PW); [[maybe_unused]] f32x2* bbar = (f32x2*)(ws + WS_BBAR); [[maybe_unused]] float* Kk = (float*)(ws + WS_KK); \
    [[maybe_unused]] bf16_t* win_t = (bf16_t*)(ws + WS_WIN); [[maybe_unused]] bf16_t* wo_t = (bf16_t*)(ws + WS_WO); [[maybe_unused]] bf16_t* wgu_t = (bf16_t*)(ws + WS_WGU); \
    [[maybe_unused]] bf16_t* wdn_t = (bf16_t*)(ws + WS_WDN); [[maybe_unused]] bf16_t* wglu_t = (bf16_t*)(ws + WS_WGLU); \
    [[maybe_unused]] bf16_t* btout = (bf16_t*)(ws + WS_BTOUT); [[maybe_unused]] bf16_t* w1m = (bf16_t*)(ws + WS_W1); \
    [[maybe_unused]] bf16_t* hmod = (bf16_t*)(ws + WS_HMOD); [[maybe_unused]] bf16_t* zmain = (bf16_t*)(ws + WS_ZMAIN); [[maybe_unused]] bf16_t* apr = (bf16_t*)(ws + WS_APR); \
    [[maybe_unused]] float* Sst = (float*)(ws + WS_S); [[maybe_unused]] bf16_t* yg = (bf16_t*)(ws + WS_YG); [[maybe_unused]] bf16_t* ymix = (bf16_t*)(ws + WS_YMIX); [[maybe_unused]] bf16_t* hid = (bf16_t*)(ws + WS_HID); \
    [[maybe_unused]] float* xres = ka->out; [[maybe_unused]] const float* modl = mod + (size_t)l * 8 * 6144;

#define XB_TMO      128
#define XB_XCNT(j)  (256  + 64 * (j))
#define XB_XSUB(j)  (1280 + 64 * (j))
#define XB_XGEN(j)  (2304 + 64 * (j))
#define XB_TOP      3328
#define XB_TOPGEN   3392
#define XB_SPIN_CAP (1u << 18)
constexpr int XB_LDS_OFF = 131072 + 14336;
__device__ __forceinline__ unsigned xb_ld(unsigned* p)              { return __hip_atomic_load(p, __ATOMIC_RELAXED, __HIP_MEMORY_SCOPE_AGENT); }
__device__ __forceinline__ unsigned xb_add(unsigned* p, unsigned v) { return __hip_atomic_fetch_add(p, v, __ATOMIC_RELAXED, __HIP_MEMORY_SCOPE_AGENT); }
__device__ __forceinline__ unsigned xb_xcc_id() { return (unsigned)__builtin_amdgcn_s_getreg((3 << 11) | 20) & 0xFu; }
#define XB_SPIN(cond, bar) do { unsigned _sp = 0; while (cond) { __builtin_amdgcn_s_sleep(1); \
    if ((++_sp & 255u) == 0u) { if (xb_ld(&(bar)[XB_TMO])) break; if (_sp > XB_SPIN_CAP) { atomicAdd(&(bar)[XB_TMO], 1u); break; } } } } while (0)
__device__ __forceinline__ void xcd_barrier_complete(unsigned* bar, unsigned x, unsigned& nloc, unsigned& nx) {
    const unsigned G = (unsigned)GRID;
    unsigned sum, cnt, mine, sp = 0u;
    for (;;) {
        sum = 0u; cnt = 0u; mine = 0u;
#pragma unroll
        for (unsigned j = 0; j < 16; ++j) { const unsigned c = xb_ld(&bar[XB_XCNT(j)]); sum += c; cnt += (c > 0u) ? 1u : 0u; mine = (j == x) ? c : mine; }
        if (sum == G) break;
        __builtin_amdgcn_s_sleep(1);
        if ((++sp & 255u) == 0u) { if (xb_ld(&bar[XB_TMO])) break; if (sp > XB_SPIN_CAP) { atomicAdd(&bar[XB_TMO], 1u); break; } }
    }
    nloc = mine > 0u ? mine : 1u; nx = cnt > 0u ? cnt : 1u;
}
__device__ __forceinline__ void grid_bar(int wave, unsigned char* smem) {
    asm volatile("s_waitcnt vmcnt(0)" ::: "memory");
    __syncthreads();
    asm volatile("" : "+s"(wave));
    if (wave == 0 && fresh_lane() == 0) {
        const CAS Args* ka = fresh_args(); unsigned* bar = (unsigned*)(ka->ws + WS_CTL) + CW_XB;
        volatile LAS unsigned* st = (volatile LAS unsigned*)((LAS unsigned char*)smem + XB_LDS_OFF);
        const unsigned x = xb_xcc_id();
        __builtin_amdgcn_s_waitcnt(0);
        unsigned nloc = st[0], nx = st[1];
        if (nloc == 0u) { xcd_barrier_complete(bar, x, nloc, nx); st[0] = nloc; st[1] = nx; }
        const unsigned old = xb_add(&bar[XB_XSUB(x)], 1u);
        const unsigned gen = old / nloc;
        if (old + 1u == (gen + 1u) * nloc) {
            __builtin_amdgcn_fence(__ATOMIC_RELEASE, "agent");
            asm volatile("s_waitcnt vmcnt(0)" ::: "memory");
            const unsigned og = xb_add(&bar[XB_TOP], 1u);
            const unsigned tg = og / nx;
            if (og + 1u == (tg + 1u) * nx) xb_add(&bar[XB_TOPGEN], 1u);
            else XB_SPIN(xb_ld(&bar[XB_TOPGEN]) == tg, bar);
            __builtin_amdgcn_fence(__ATOMIC_ACQUIRE, "agent");
            xb_add(&bar[XB_XGEN(x)], 1u);
            asm volatile("s_waitcnt vmcnt(0)" ::: "memory");
        } else {
            XB_SPIN(xb_ld(&bar[XB_XGEN(x)]) == gen, bar);
            __builtin_amdgcn_fence(__ATOMIC_ACQUIRE, "agent");
            asm volatile("s_waitcnt vmcnt(0)" ::: "memory");
        }
    }
    __syncthreads();
}
#define PH_T0() unsigned long long ph_t0_ = 0; if (AMP_MASK) ph_t0_ = __builtin_amdgcn_s_memrealtime()
#define PH_AMP(i) do { if (AMP_MASK & (1u << (i))) { const unsigned long long t1_ = __builtin_amdgcn_s_memrealtime(); while (__builtin_amdgcn_s_memrealtime() - t1_ < t1_ - ph_t0_) __builtin_amdgcn_s_sleep(8); } } while (0)
__device__ __forceinline__ void transpose_item(const float* W, int K, int N, bf16_t* WT, int mode, float* scr, int item, int lane) {
    const int nblk = N / 32, kb = item / nblk, nb = item % nblk, k0 = 64 * kb, n0 = 32 * nb;
    int drow0 = mode == 0 ? n0 : (256 * (n0 >> 7) + (n0 & 127) + (mode == 2 ? 128 : 0));
    if (mode == 3) {
        const int seg = n0 >> 8, c = n0 & 255, pr = 256 * (c >> 7) + (c & 127);
        drow0 = seg == 0 ? pr : seg == 1 ? 512 + c : seg == 2 ? pr + 128 : seg == 3 ? 768 + c : seg == 4 ? 1024 + pr : seg == 5 ? 1024 + pr + 128 : n0;
    }
    float wv_[32];
#pragma unroll
    for (int i = 0; i < 32; ++i) wv_[i] = W[(size_t)(k0 + 2 * i + (lane >> 5)) * N + n0 + (lane & 31)];
#pragma unroll
    for (int i = 0; i < 32; ++i) scr[(2 * i + (lane >> 5)) * 33 + (lane & 31)] = wv_[i];
    asm volatile("s_waitcnt lgkmcnt(0)" ::: "memory");
    const int c = lane & 7;
#pragma unroll
    for (int j = 0; j < 4; ++j) { const int n = (lane >> 3) + 8 * j; const float* s = scr + (8 * c) * 33 + n;
        u32x4 o; o.x = cvt_pk_bf16(s[0 * 33], s[1 * 33]); o.y = cvt_pk_bf16(s[2 * 33], s[3 * 33]); o.z = cvt_pk_bf16(s[4 * 33], s[5 * 33]); o.w = cvt_pk_bf16(s[6 * 33], s[7 * 33]);
        *(u32x4*)(WT + (size_t)(drow0 + n) * K + k0 + 8 * c) = o; }
    asm volatile("s_waitcnt lgkmcnt(0)" ::: "memory");
}

__device__ __forceinline__ void fused_pool_item(const float* W, const float* poolw, const float* scale, bf16_t* WT, float* scr, int item, int lane) {
    const int K = DM, N = DM, nblk = N / 32, kb = item / nblk, nb = item % nblk, k0 = 64 * kb, n0 = 32 * nb;
    const int n = lane & 31, half = lane >> 5;
    float a[32];
#pragma unroll
    for (int i = 0; i < 32; ++i) a[i] = 0.f;
    for (int d = 0; d < 64; ++d) {
        const float wv = W[(size_t)(k0 + d) * N + n0 + n] * scale[d];
#pragma unroll
        for (int i = 0; i < 32; ++i) a[i] += poolw[(2 * i + half) * 64 + d] * wv;
    }
#pragma unroll
    for (int i = 0; i < 32; ++i) scr[(2 * i + half) * 33 + n] = a[i];
    asm volatile("s_waitcnt lgkmcnt(0)" ::: "memory");
    const int c = lane & 7;
#pragma unroll
    for (int j = 0; j < 4; ++j) { const int nn = (lane >> 3) + 8 * j; const float* s = scr + (8 * c) * 33 + nn;
        u32x4 o; o.x = cvt_pk_bf16(s[0 * 33], s[1 * 33]); o.y = cvt_pk_bf16(s[2 * 33], s[3 * 33]); o.z = cvt_pk_bf16(s[4 * 33], s[5 * 33]); o.w = cvt_pk_bf16(s[6 * 33], s[7 * 33]);
        *(u32x4*)(WT + (size_t)(n0 + nn) * K + k0 + 8 * c) = o; }
    asm volatile("s_waitcnt lgkmcnt(0)" ::: "memory");
}

__device__ __forceinline__ void unpack8(const u32x4 w, float (&f)[8]) {
    f[0] = __uint_as_float(w.x << 16); f[1] = __uint_as_float(w.x & 0xffff0000u); f[2] = __uint_as_float(w.y << 16); f[3] = __uint_as_float(w.y & 0xffff0000u);
    f[4] = __uint_as_float(w.z << 16); f[5] = __uint_as_float(w.z & 0xffff0000u); f[6] = __uint_as_float(w.w << 16); f[7] = __uint_as_float(w.w & 0xffff0000u);
}
struct MixRaw { u32x4 ra[2][4], rb[3], rc[4]; };
__device__ __forceinline__ void mix_load(MixRaw& R, int item, const bf16_t* zm, int tq, int ch) {
    const int b = item >> 8, s0 = (item & 255) * 32; const size_t row0 = (size_t)b * SEQ + s0;
    const u32x4 zero4 = (u32x4){0u, 0u, 0u, 0u};
#pragma unroll
    for (int it = 0; it < 2; ++it) { const int tk = tq + 16 * it, s = s0 + tk; const size_t row = row0 + tk;
        R.ra[it][0] = *(const u32x4*)(zm + row * ZW + 256 + ch);
#pragma unroll
        for (int k = 0; k < 3; ++k) R.ra[it][1 + k] = (s - 2 + k >= 0) ? *(const u32x4*)(zm + (row - 2 + k) * ZW + ch) : zero4; }
#pragma unroll
    for (int it = 0; it < 3; ++it) { const int j = tq + 16 * it; R.rb[it] = (s0 - 16 + j >= 0) ? *(const u32x4*)(zm + (row0 + j - 16) * ZW + 512 + ch) : zero4; }
#pragma unroll
    for (int it = 0; it < 4; ++it) { const int j = tq + 16 * it; R.rc[it] = (j < 62 && s0 - 30 + j >= 0) ? *(const u32x4*)(zm + (row0 + j - 30) * ZW + 768 + ch) : zero4; }
}
__device__ __forceinline__ void mixers_run(int it0, int it1, const bf16_t* zm, bf16_t* ymix, const float* scw,
                                           const float* dww, const float* dwb, const float* clg, const float* clb, unsigned char* smem, int wv) {
    const int lane = fresh_lane(), tid = wv * 64 + lane;
    const int ch = (tid & 31) * 8, tq = tid >> 5;
    const int c = tid & 255, th = tid >> 8;
    float* P = (float*)smem;
    float* H = (float*)(smem + 49152);
    float* O = (float*)(smem + 112640);
    f32x4 wa0[3], wa1[3]; float w[31];
#pragma unroll
    for (int k = 0; k < 3; ++k) { wa0[k] = *(const f32x4*)(scw + k * 256 + ch); wa1[k] = *(const f32x4*)(scw + k * 256 + ch + 4); }
#pragma unroll
    for (int k = 0; k < 31; ++k) w[k] = dww[k * 256 + c];
    const float bias = dwb[c];
    const int hl = lane & 31, hf = lane >> 5;
    const f32x4 gq0 = *(const f32x4*)(clg + 8 * hl), gq1 = *(const f32x4*)(clg + 8 * hl + 4), bq0 = *(const f32x4*)(clb + 8 * hl), bq1 = *(const f32x4*)(clb + 8 * hl + 4);
    MixRaw R;
    if (it0 < it1) mix_load(R, it0, zm, tq, ch);
    for (int item = it0; item < it1; ++item) {
        const int b = item >> 8, s0 = (item & 255) * 32; const size_t row0 = (size_t)b * SEQ + s0;
#pragma unroll
        for (int it = 0; it < 3; ++it) { const int j = tq + 16 * it; float v[8]; unpack8(R.rb[it], v);
            *(f32x4*)(P + j * 256 + ch) = (f32x4){v[0], v[1], v[2], v[3]}; *(f32x4*)(P + j * 256 + ch + 4) = (f32x4){v[4], v[5], v[6], v[7]}; }
#pragma unroll
        for (int it = 0; it < 4; ++it) { const int j = tq + 16 * it; if (j < 62) { float v[8]; unpack8(R.rc[it], v);
            *(f32x4*)(H + j * 256 + ch) = (f32x4){v[0], v[1], v[2], v[3]}; *(f32x4*)(H + j * 256 + ch + 4) = (f32x4){v[4], v[5], v[6], v[7]}; } }
        __syncthreads();
#pragma unroll
        for (int it = 0; it < 2; ++it) {
            float zb[8], a[8]; unpack8(R.ra[it][0], zb);
#pragma unroll
            for (int j = 0; j < 8; ++j) a[j] = 0.f;
#pragma unroll
            for (int k = 0; k < 3; ++k) { float pz[8]; unpack8(R.ra[it][1 + k], pz);
                a[0] += wa0[k][0] * pz[0]; a[1] += wa0[k][1] * pz[1]; a[2] += wa0[k][2] * pz[2]; a[3] += wa0[k][3] * pz[3];
                a[4] += wa1[k][0] * pz[4]; a[5] += wa1[k][1] * pz[5]; a[6] += wa1[k][2] * pz[6]; a[7] += wa1[k][3] * pz[7]; }
#pragma unroll
            for (int j = 0; j < 8; ++j) a[j] *= zb[j];
            st8(ymix + (row0 + tq + 16 * it) * DM + ch, a);
        }
        if (item + 1 < it1) mix_load(R, item + 1, zm, tq, ch);
        {
            const int gI = wv >> 1, ww = 2 << gI, chb = gI * 64 + (lane & 7) * 8, tl = (lane >> 3) + 8 * (wv & 1);
#pragma unroll
            for (int it = 0; it < 2; ++it) {
                const int t = tl + 16 * it, s = s0 + t; const int cntv = (s + 1 < ww) ? (s + 1) : ww;
                f32x4 a0 = (f32x4){0.f, 0.f, 0.f, 0.f}, a1 = a0;
                for (int j = 0; j < ww; ++j) { a0 += *(const f32x4*)(P + (16 + t - j) * 256 + chb); a1 += *(const f32x4*)(P + (16 + t - j) * 256 + chb + 4); }
                const float inv = __builtin_amdgcn_rcpf((float)cntv);
                const f32x4 z0 = *(const f32x4*)(P + (16 + t) * 256 + chb), z1 = *(const f32x4*)(P + (16 + t) * 256 + chb + 4);
                a0 = a0 * inv - z0; a1 = a1 * inv - z1;
                float o[8] = {a0[0], a0[1], a0[2], a0[3], a1[0], a1[1], a1[2], a1[3]};
                st8(ymix + (row0 + t) * DM + 256 + chb, o);
            }
        }
        {
            float win[46];
#pragma unroll
            for (int q = 0; q < 46; ++q) win[q] = H[(th * 16 + q) * 256 + c];
#pragma unroll
            for (int j = 0; j < 16; ++j) { float o = bias;
#pragma unroll
                for (int k = 0; k < 31; ++k) o += w[k] * win[j + k];
                O[(th * 16 + j) * 256 + c] = o; }
        }
        __syncthreads();
#pragma unroll
        for (int q = 0; q < 2; ++q) {
            const int t = wv * 4 + 2 * q + hf;
            const f32x4 v0 = *(const f32x4*)(O + t * 256 + 8 * hl), v1 = *(const f32x4*)(O + t * 256 + 8 * hl + 4);
            float s = ((v0[0] + v0[1]) + (v0[2] + v0[3])) + ((v1[0] + v1[1]) + (v1[2] + v1[3]));
#pragma unroll
            for (int o = 1; o < 32; o <<= 1) s += shfl_xor_l(s, o, lane);
            const float mean = s * (1.0f / 256.0f);
            const f32x4 d0 = v0 - mean, d1 = v1 - mean;
            float qv = ((d0[0] * d0[0] + d0[1] * d0[1]) + (d0[2] * d0[2] + d0[3] * d0[3])) + ((d1[0] * d1[0] + d1[1] * d1[1]) + (d1[2] * d1[2] + d1[3] * d1[3]));
#pragma unroll
            for (int o = 1; o < 32; o <<= 1) qv += shfl_xor_l(qv, o, lane);
            const float rstd = __builtin_amdgcn_rsqf(qv * (1.0f / 256.0f) + LN_EPS);
            const f32x4 y0 = d0 * rstd * gq0 + bq0, y1 = d1 * rstd * gq1 + bq1;
            u32x4 o4; o4.x = cvt_pk_bf16(siluf_(y0[0]), siluf_(y0[1])); o4.y = cvt_pk_bf16(siluf_(y0[2]), siluf_(y0[3]));
            o4.z = cvt_pk_bf16(siluf_(y1[0]), siluf_(y1[1])); o4.w = cvt_pk_bf16(siluf_(y1[2]), siluf_(y1[3]));
            *(u32x4*)(ymix + (row0 + t) * DM + 512 + 8 * hl) = o4;
        }
        __syncthreads();
    }
}

__global__ void __launch_bounds__(NTHREADS, 2) trunk_fwd(Args args) {
    extern __shared__ __attribute__((aligned(16))) unsigned char smem[];
    cg::grid_group grid = cg::this_grid();
    LAS unsigned char* lds = (LAS unsigned char*)smem;
    const int tid = threadIdx.x, lane = tid & 63, wave = __builtin_amdgcn_readfirstlane(tid >> 6);
    const int bid = blockIdx.x, G = gridDim.x;
    const int gtid = bid * NTHREADS + tid, GT = G * NTHREADS;

    if (tid < 4) ((unsigned*)(smem + XB_LDS_OFF))[tid] = 0u;
    if (tid == 0) (void)xb_add((unsigned*)(args.ws + WS_CTL) + CW_XB + XB_XCNT(xb_xcc_id()), 1u);
    __syncthreads();
    PH_T0();
    {
        PH_PTRS0
        float* scr = (float*)(smem + wave * 16384);
        const int gw = bid * 8 + wave, NGW = G * 8;
        constexpr int I_IN = 16 * 56, I_O = 16 * 32, I_G = 16 * 88, I_D = 44 * 32, I_GLU = 4 * 8, I_L = I_IN + I_O + 2 * I_G + I_D + I_GLU;
        for (int it = gw; it < DEPTH * I_L; it += NGW) {
            const int l = it / I_L; int r = it % I_L;
            if (r < I_IN) { transpose_item(ka->in[4] + (size_t)l * DM * INW, DM, INW, win_t + (size_t)l * INW * DM, 3, scr, r, lane); continue; } r -= I_IN;
            if (r < I_O) {
                const int kb = r / 32;
                if (kb >= 4 && kb < 8) fused_pool_item(ka->in[23] + (size_t)l * DM * DM, ka->in[7] + (size_t)l * 16384 + (kb - 4) * 4096, ka->in[8] + l * 256 + (kb - 4) * 64, wo_t + (size_t)l * DM * DM, scr, r, lane);
                else transpose_item(ka->in[23] + (size_t)l * DM * DM, DM, DM, wo_t + (size_t)l * DM * DM, 0, scr, r, lane);
                continue; } r -= I_O;
            if (r < I_G) { transpose_item(ka->in[26] + (size_t)l * DM * FF, DM, FF, wgu_t + (size_t)l * 2 * FF * DM, 1, scr, r, lane); continue; } r -= I_G;
            if (r < I_G) { transpose_item(ka->in[27] + (size_t)l * DM * FF, DM, FF, wgu_t + (size_t)l * 2 * FF * DM, 2, scr, r, lane); continue; } r -= I_G;
            if (r < I_D) { transpose_item(ka->in[28] + (size_t)l * FF * DM, FF, DM, wdn_t + (size_t)l * DM * FF, 0, scr, r, lane); continue; } r -= I_D;
            transpose_item(ka->in[21] + (size_t)l * 65536, 256, 256, wglu_t + (size_t)l * 65536, 0, scr, r, lane);
        }
        __syncthreads();
        float* cond = (float*)smem; float* red = (float*)(smem + 32768);
        for (int i = tid; i < NB * DM; i += NTHREADS) { const float v = ka->in[1][i]; cond[i] = siluf_(v); }
        __syncthreads();
        for (int item = bid; item < DEPTH * 96; item += G) {
            const int l = item / 96, n = (item % 96) * 64 + lane;
            const float* Wp = ka->in[2] + (size_t)l * DM * 6144 + n;
            float a[8];
#pragma unroll
            for (int q = 0; q < 8; ++q) a[q] = 0.f;
            for (int k0 = wave * 128; k0 < wave * 128 + 128; k0 += 16) {
                float wv_[16];
#pragma unroll
                for (int j = 0; j < 16; ++j) wv_[j] = Wp[(size_t)(k0 + j) * 6144];
#pragma unroll
                for (int j = 0; j < 16; ++j)
#pragma unroll
                    for (int q = 0; q < 8; ++q) a[q] += cond[q * DM + k0 + j] * wv_[j];
            }
#pragma unroll
            for (int q = 0; q < 8; ++q) red[(wave * 8 + q) * 64 + lane] = a[q];
            __syncthreads();
            float s = 0.f;
#pragma unroll
            for (int w2 = 0; w2 < 8; ++w2) s += red[(w2 * 8 + wave) * 64 + lane];
            mod[(size_t)(l * 8 + wave) * 6144 + n] = s + ka->in[3][l * 6144 + n];
            __syncthreads();
        }
        if (gtid < DEPTH * 16 * 64) {
            const int idx = gtid, lg = idx >> 6;
            const float dt = __expf(ka->in[15][lg]), lr = ka->in[13][idx], li = ka->in[14][idx];
            const float a = lr * dt, tt = li * dt * 0.15915494309189535f;
            float lbr = 0.f, lbi = 0.f;
            for (int k = 0; k <= 32; ++k) {
                const float mag = __expf((float)k * a), tk = (float)k * tt, frc = tk - rintf(tk);
                const float cr = mag * __builtin_amdgcn_cosf(frc), ci = mag * __builtin_amdgcn_sinf(frc);
                pw[idx * 33 + k] = (f32x2){cr, ci};
                if (k == 1) { lbr = cr; lbi = ci; }
            }
            const float nr = lbr - 1.0f, ni = lbi, inv = 1.0f / (lr * lr + li * li);
            const float qr = (nr * lr + ni * li) * inv, qi = (ni * lr - nr * li) * inv;
            for (int h = 0; h < 16; ++h) { const float br = ka->in[16][idx * 16 + h], bi = ka->in[17][idx * 16 + h];
                bbar[idx * 16 + h] = (f32x2){qr * br - qi * bi, qr * bi + qi * br}; }
        }
    }
    grid.sync();
    {
        PH_PTRS0
        for (int idx = gtid; idx < DEPTH * 16 * 32 * 256; idx += GT) {
            const int hp = idx & 15, h = (idx >> 4) & 15, k = (idx >> 8) & 31, lg = idx >> 13;
            const float* cre = ka->in[18] + (size_t)(lg * 16 + h) * 64; const float* cim = ka->in[19] + (size_t)(lg * 16 + h) * 64;
            float sum = 0.f;
            for (int p = 0; p < 64; ++p) { const f32x2 w = pw[(lg * 64 + p) * 33 + k], bb = bbar[(lg * 64 + p) * 16 + hp];
                const float tr = w.x * bb.x - w.y * bb.y, ti = w.x * bb.y + w.y * bb.x; sum += cre[p] * tr - cim[p] * ti; }
            Kk[idx] = sum;
        }
        for (int idx = gtid; idx < DEPTH * 16 * 256 * 32; idx += GT) {
            const int s = idx & 31, row = (idx >> 5) & 255, lg = idx >> 13;
            bf16_t* dst = w1m + ((size_t)(lg * 256 + row) * 512 + s * 16);
            float v[16];
            if (row < 128) { const int p = row >> 1, ri = row & 1; const f32x2 w = pw[(lg * 64 + p) * 33 + (31 - s)];
#pragma unroll
                for (int hp = 0; hp < 16; ++hp) { const f32x2 bb = bbar[(lg * 64 + p) * 16 + hp]; v[hp] = ri ? (w.x * bb.y + w.y * bb.x) : (w.x * bb.x - w.y * bb.y); } }
            else {
#pragma unroll
                for (int hp = 0; hp < 16; ++hp) v[hp] = 0.f;
            }
            u32x4 o0, o1; o0.x = cvt_pk_bf16(v[0], v[1]); o0.y = cvt_pk_bf16(v[2], v[3]); o0.z = cvt_pk_bf16(v[4], v[5]); o0.w = cvt_pk_bf16(v[6], v[7]);
            o1.x = cvt_pk_bf16(v[8], v[9]); o1.y = cvt_pk_bf16(v[10], v[11]); o1.z = cvt_pk_bf16(v[12], v[13]); o1.w = cvt_pk_bf16(v[14], v[15]);
            *(u32x4*)dst = o0; *(u32x4*)(dst + 8) = o1;
        }
        for (int idx = gtid; idx < DEPTH * 16 * 32 * 16 * 8; idx += GT) {
            const int pc = idx & 7, h = (idx >> 3) & 15, t = (idx >> 7) & 31, lg = idx >> 12;
            bf16_t* dst = btout + ((size_t)(lg * 512 + t * 16 + h) * KSSM + 512 + pc * 16);
            const float* cre = ka->in[18] + (size_t)(lg * 16 + h) * 64 + pc * 8; const float* cim = ka->in[19] + (size_t)(lg * 16 + h) * 64 + pc * 8;
            float v[16];
#pragma unroll
            for (int j = 0; j < 8; ++j) { const f32x2 w = pw[(lg * 64 + pc * 8 + j) * 33 + t + 1]; const float cr = cre[j], ci = cim[j];
                v[2 * j] = cr * w.x - ci * w.y; v[2 * j + 1] = -(cr * w.y + ci * w.x); }
            u32x4 o0, o1; o0.x = cvt_pk_bf16(v[0], v[1]); o0.y = cvt_pk_bf16(v[2], v[3]); o0.z = cvt_pk_bf16(v[4], v[5]); o0.w = cvt_pk_bf16(v[6], v[7]);
            o1.x = cvt_pk_bf16(v[8], v[9]); o1.y = cvt_pk_bf16(v[10], v[11]); o1.z = cvt_pk_bf16(v[12], v[13]); o1.w = cvt_pk_bf16(v[14], v[15]);
            *(u32x4*)dst = o0; *(u32x4*)(dst + 8) = o1;
        }
        for (int idx = gtid; idx < 8 * NB * DM; idx += GT) {
            const int c = idx & (DM - 1), bb = (idx >> 10) & 7, j = idx >> 13, lj = j >> 1, wh = j & 1;
            const float* ml = mod + (size_t)(lj * 8 + bb) * 6144;
            const float gg = ml[(wh ? 5120 : 2048) + c], ps = ml[(wh ? 4096 : 1024) + c], ph = ml[(wh ? 3072 : 0) + c];
            const float lg = (wh ? ka->in[29] : ka->in[24])[lj * DM + c], lb = (wh ? ka->in[30] : ka->in[25])[lj * DM + c];
            float hs = 0.f, hh = 0.f;
            if (!wh) { hs = ml[4096 + c]; hh = ml[3072 + c]; }
            else if (lj + 1 < DEPTH) { const float* mn = mod + (size_t)((lj + 1) * 8 + bb) * 6144; hs = mn[1024 + c]; hh = mn[c]; }
            const float pa = ALPHA / (1.0f + ps);
            float* t = (float*)(ws + WS_LNT) + (size_t)(j * 8 + bb) * 5120 + c;
            t[0] = 1.0f + gg; t[1024] = pa; t[2048] = ph * pa; t[3072] = lg * (1.0f + hs); t[4096] = lb * (1.0f + hs) + hh;
        }
        for (size_t idx0 = gtid; idx0 < (size_t)MTOK * DM / 8; idx0 += (size_t)4 * GT) {
            f32x4 xa[4], xb[4];
#pragma unroll
            for (int uu = 0; uu < 4; ++uu) { const size_t e = (idx0 + (size_t)uu * GT) * 8; xa[uu] = *(const f32x4*)(ka->in[0] + e); xb[uu] = *(const f32x4*)(ka->in[0] + e + 4); }
#pragma unroll
            for (int uu = 0; uu < 4; ++uu) {
                const size_t e = (idx0 + (size_t)uu * GT) * 8; const int col = (int)(e & (DM - 1)); const int b = (int)(e >> 23);
                const float* mb = mod + (size_t)b * 6144;
                const f32x4 sh0 = *(const f32x4*)(mb + col), sh1 = *(const f32x4*)(mb + col + 4), sc0 = *(const f32x4*)(mb + 1024 + col), sc1 = *(const f32x4*)(mb + 1024 + col + 4);
                const f32x4 h0 = xa[uu] * (sc0 + 1.0f) + sh0, h1 = xb[uu] * (sc1 + 1.0f) + sh1;
                u32x4 w; w.x = cvt_pk_bf16(h0[0], h0[1]); w.y = cvt_pk_bf16(h0[2], h0[3]); w.z = cvt_pk_bf16(h1[0], h1[1]); w.w = cvt_pk_bf16(h1[2], h1[3]);
                *(u32x4*)(hmod + e) = w;
            }
        }
    }
    grid_bar(wave, smem);
    { PH_PTRS0
    for (int idx = gtid; idx < DEPTH * 16 * 32 * 16 * 32; idx += GT) {
        const int s = idx & 31, h = (idx >> 5) & 15, t = (idx >> 9) & 31, lg = idx >> 14;
        bf16_t* dst = btout + ((size_t)(lg * 512 + t * 16 + h) * KSSM + s * 16);
        float v[16];
        if (s <= t) { const float* kp = Kk + ((size_t)(lg * 32 + (t - s)) * 16 + h) * 16; const float dd = (s == t) ? ka->in[20][lg * 16 + h] : 0.f;
#pragma unroll
            for (int hp = 0; hp < 16; ++hp) v[hp] = kp[hp] + (hp == h ? dd : 0.f); }
        else {
#pragma unroll
            for (int hp = 0; hp < 16; ++hp) v[hp] = 0.f;
        }
        u32x4 o0, o1; o0.x = cvt_pk_bf16(v[0], v[1]); o0.y = cvt_pk_bf16(v[2], v[3]); o0.z = cvt_pk_bf16(v[4], v[5]); o0.w = cvt_pk_bf16(v[6], v[7]);
        o1.x = cvt_pk_bf16(v[8], v[9]); o1.y = cvt_pk_bf16(v[10], v[11]); o1.z = cvt_pk_bf16(v[12], v[13]); o1.w = cvt_pk_bf16(v[14], v[15]);
        *(u32x4*)dst = o0; *(u32x4*)(dst + 8) = o1;
    }
    }
    PH_AMP(0);

    for (int l = 0; l < DEPTH; ++l) {
        for (int rep = 0; rep < REP_MIX; ++rep) {
        { PH_T0();
        {
            PH_PTRS
            pg8::Gemm g{hmod, win_t + (size_t)l * INW * DM, DM, DM, DM};
            pg8::StaticOrder S; S.init(MTOK, INW, G, bid);
            pg8::EpiZ E{zmain, apr, ka->in[5] + l * INW};
            pg8::gemm_phase<pg8::EpiZ, pg8::StaticOrder, true>(lds, g, S, E, wave);
        }
        PH_AMP(1); }
        grid_bar(wave, smem);
        { PH_T0();
        {
            PH_PTRS
            int bidl = bid; asm volatile("" : "+s"(bidl));
            if (bidl < 128) {
                const int gq = bidl >> 3;
                {
                    pg8::Gemm g{apr, w1m + (size_t)l * 4096 * 512, 512, KSSM, 512};
                    pg8::OneUnit S{bidl, gq, true};
                    pg8::EpiStates E{Sst};
                    pg8::gemm_phase<pg8::EpiStates, pg8::OneUnit, true>(lds, g, S, E, wave);
                }
                asm volatile("s_waitcnt vmcnt(0)" ::: "memory");
                __syncthreads();
                {
                    int wvl = wave; asm volatile("" : "+s"(wvl));
                    const int ln = fresh_lane(); const int rowbase = bidl * NCH + wvl * 32;
                    const f32x2 mult = pw[((l * 16 + gq) * 64 + ln) * 33 + 32];
                    f32x2 sv[32];
#pragma unroll
                    for (int j = 0; j < 32; ++j) sv[j] = *(const f32x2*)(Sst + (size_t)(rowbase + j) * 128 + 2 * ln);
                    float er = 0.f, ei = 0.f;
#pragma unroll
                    for (int j = 0; j < 32; ++j) { const float nr = mult.x * er - mult.y * ei + sv[j].x, ni = mult.x * ei + mult.y * er + sv[j].y; er = nr; ei = ni; }
                    f32x2* ex = (f32x2*)(smem + 131072);
                    ex[wvl * 64 + ln] = (f32x2){er, ei};
                    float mr = mult.x, mi = mult.y;
#pragma unroll
                    for (int q = 0; q < 5; ++q) { const float nr = mr * mr - mi * mi, ni = 2.0f * mr * mi; mr = nr; mi = ni; }
                    __syncthreads();
                    float xr = 0.f, xi = 0.f;
                    for (int w2 = 0; w2 < wvl; ++w2) { const f32x2 e = ex[w2 * 64 + ln]; const float nr = mr * xr - mi * xi + e.x, ni = mr * xi + mi * xr + e.y; xr = nr; xi = ni; }
#pragma unroll
                    for (int j = 0; j < 32; ++j) {
                        *(unsigned*)(apr + (size_t)(rowbase + j) * KSSM + 512 + 2 * ln) = cvt_pk_bf16(xr, xi);
                        const float nr = mult.x * xr - mult.y * xi + sv[j].x, ni = mult.x * xi + mult.y * xr + sv[j].y; xr = nr; xi = ni;
                    }
                }
                asm volatile("s_waitcnt vmcnt(0)" ::: "memory");
                __syncthreads();
                {
                    pg8::Gemm g{apr, btout + (size_t)l * 8192 * KSSM, KSSM, KSSM, KSSM};
                    pg8::PairOrder S{bidl, gq * 2};
                    pg8::EpiSsmOut E{yg};
                    pg8::gemm_phase<pg8::EpiSsmOut, pg8::PairOrder, true>(lds, g, S, E, wave);
                }
                __syncthreads();
            }
            const int it0 = bidl < 128 ? bidl * 5 : 640 + (bidl - 128) * 11, it1 = it0 + (bidl < 128 ? 5 : 11);
            mixers_run(it0, it1, zmain, ymix, ka->in[6] + l * 768, ka->in[9] + l * 7936,
                       ka->in[10] + l * 256, ka->in[11] + l * 256, ka->in[12] + l * 256, smem, wave);
        }
        PH_AMP(2); }
        grid_bar(wave, smem);
        { PH_T0();
        {
            PH_PTRS
            pg8::Gemm g{yg, wglu_t + (size_t)l * 65536, 256, 256, 256};
            pg8::StaticOrder S; S.init(MTOK, 256, G, bid);
            pg8::EpiGlu E{yg, ymix, ka->in[22] + l * 256};
            pg8::gemm_phase<pg8::EpiGlu, pg8::StaticOrder, true>(lds, g, S, E, wave);
        }
        PH_AMP(4); }
        grid_bar(wave, smem);
        }
        { PH_T0();
        {
            PH_PTRS
            pg8::Gemm g{ymix, wo_t + (size_t)l * DM * DM, DM, DM, DM};
            pg8::RoundOrder S{bid & 7, bid >> 3};
            pg8::EpiLn E{(float*)nullptr, hmod, (const float*)(ws + WS_LNT) + (size_t)(2 * l) * 8 * 5120,
                         (unsigned long long*)(ws + WS_XCH), ctl + CW_TMO, (unsigned)(2 * l) & 7u, lds + 131072};
            pg8::gemm_phase<pg8::EpiLn, pg8::RoundOrder, true>(lds, g, S, E, wave);
        }
        PH_AMP(5); }
        grid_bar(wave, smem);
        { PH_T0();
        for (int rep = 0; rep < REP_P6; ++rep) {
            PH_PTRS
            pg8::Gemm g{hmod, wgu_t + (size_t)l * 2 * FF * DM, DM, DM, DM};
            pg8::StaticOrder S; S.init(MTOK, 2 * FF, G, bid);
            pg8::EpiSwiGlu E{hid};
            pg8::gemm_phase<pg8::EpiSwiGlu, pg8::StaticOrder, true>(lds, g, S, E, wave);
        }
        PH_AMP(6); }
        grid_bar(wave, smem);
        { PH_T0();
        {
            PH_PTRS
            const float* modn = mod + (size_t)(l + 1 < DEPTH ? l + 1 : l) * 8 * 6144;
            pg8::Gemm g{hid, wdn_t + (size_t)l * DM * FF, FF, FF, FF};
            pg8::RoundOrder S{bid & 7, bid >> 3};
            pg8::EpiLn E{(l + 1 < DEPTH) ? (float*)nullptr : xres, hmod, (const float*)(ws + WS_LNT) + (size_t)(2 * l + 1) * 8 * 5120,
                         (unsigned long long*)(ws + WS_XCH), ctl + CW_TMO, (unsigned)(2 * l + 1) & 7u, lds + 131072};
            pg8::gemm_phase<pg8::EpiLn, pg8::RoundOrder, true>(lds, g, S, E, wave);
        }
        PH_AMP(7); }
        grid_bar(wave, smem);
    }
}

extern "C" void kernel_launch(void* const* d_in, const int* in_sizes, int n_in, void* d_out, int out_size, void* d_ws, size_t ws_size, hipStream_t stream) {
    static int ready = 0;
    if (ready == 0) {
        ready = 1;
        if (n_in != 31 || out_size != MTOK * DM || ws_size < WS_END) { fprintf(stderr, "kernel_launch: unexpected shapes (n_in %d, out %d, ws %zu)\n", n_in, out_size, ws_size); ready = -1; }
        else if (hipFuncSetAttribute((const void*)trunk_fwd, hipFuncAttributeMaxDynamicSharedMemorySize, LDS_BYTES) != hipSuccess) { fprintf(stderr, "kernel_launch: hipFuncSetAttribute failed\n"); ready = -1; }
        else { int per_cu = 0; if (hipOccupancyMaxActiveBlocksPerMultiprocessor(&per_cu, (const void*)trunk_fwd, NTHREADS, LDS_BYTES) != hipSuccess || per_cu < 1) fprintf(stderr, "kernel_launch: occupancy query reports %d\n", per_cu); (void)hipGetLastError(); }
    }
    if (ready < 0) return;
    (void)hipMemsetAsync((char*)d_ws + WS_CTL, 0, CTL_BYTES, stream);
    Args a{};
    for (int i = 0; i < 31; ++i) a.in[i] = (const float*)d_in[i];
    a.out = (float*)d_out; a.ws = (unsigned char*)d_ws;
    void* kargs[] = {&a};
    hipError_t e = hipLaunchCooperativeKernel((const void*)trunk_fwd, dim3(GRID), dim3(NTHREADS), kargs, LDS_BYTES, stream);
    if (e != hipSuccess) fprintf(stderr, "kernel_launch: cooperative launch failed: %s\n", hipGetErrorString(e));
}
```

```cpp
#include <hip/hip_runtime.h>
#include <hip/hip_cooperative_groups.h>
#include <cstdio>
#include <cstdint>
namespace cg = cooperative_groups;

#define LAS __attribute__((address_space(3)))
typedef unsigned short bf16_t;
typedef short bf16x8 __attribute__((ext_vector_type(8)));
typedef float f32x4 __attribute__((ext_vector_type(4)));
typedef float f32x2 __attribute__((ext_vector_type(2)));
typedef unsigned u32x4 __attribute__((ext_vector_type(4)));
typedef unsigned u32x2 __attribute__((ext_vector_type(2)));

constexpr int DM = 1024, NB = 8, SEQ = 8192, MTOK = NB * SEQ, DEPTH = 4, FF = 2816, INW = 1792, ZW = 1024;
constexpr int CT = 32, NCH = SEQ / CT, NBC = NB * NCH, KSSM = 640;
constexpr float ALPHA = 1.681792830507429f;
constexpr float LN_EPS = 1e-5f;
constexpr int NTHREADS = 512, GRID = 256;
constexpr unsigned AMP_MASK = 0u;
constexpr int REP_MIX = 1, REP_P6 = 1;

constexpr size_t MiB = 1u << 20;
constexpr size_t WS_CTL = 0, CTL_BYTES = 1 * MiB;
constexpr size_t WS_XCH = 1 * MiB;
constexpr size_t WS_MOD = 3 * MiB;
constexpr size_t WS_PW = 4 * MiB;
constexpr size_t WS_BBAR = 6 * MiB;
constexpr size_t WS_KK = 7 * MiB;
constexpr size_t WS_WIN = 10 * MiB;
constexpr size_t WS_WO = 24 * MiB;
constexpr size_t WS_WGU = 32 * MiB;
constexpr size_t WS_WDN = 76 * MiB;
constexpr size_t WS_WGLU = 98 * MiB;
constexpr size_t WS_BTOUT = 100 * MiB;
constexpr size_t WS_W1 = 140 * MiB;
constexpr size_t WS_HMOD = 156 * MiB;
constexpr size_t WS_ZMAIN = 284 * MiB;
constexpr size_t WS_APR = 476 * MiB;
constexpr size_t WS_S = 516 * MiB;
constexpr size_t WS_YG = 532 * MiB;
constexpr size_t WS_YMIX = 564 * MiB;
constexpr size_t WS_HID = 284 * MiB;
constexpr size_t WS_LNT = 692 * MiB;
constexpr size_t WS_END = 694 * MiB;
constexpr int CW_TMO = 0, CW_CNT = 1024, CW_XB = 32768;

constexpr int LDS_BYTES = 147456;

__device__ __forceinline__ unsigned cvt_pk_bf16(float lo, float hi) { unsigned r; asm volatile("v_cvt_pk_bf16_f32 %0, %1, %2" : "=v"(r) : "v"(lo), "v"(hi)); return r; }
__device__ __forceinline__ void ld8(const bf16_t* p, float (&f)[8]) {
    const u32x4 w = *(const u32x4*)p;
    f[0] = __uint_as_float(w.x << 16); f[1] = __uint_as_float(w.x & 0xffff0000u);
    f[2] = __uint_as_float(w.y << 16); f[3] = __uint_as_float(w.y & 0xffff0000u);
    f[4] = __uint_as_float(w.z << 16); f[5] = __uint_as_float(w.z & 0xffff0000u);
    f[6] = __uint_as_float(w.w << 16); f[7] = __uint_as_float(w.w & 0xffff0000u);
}
__device__ __forceinline__ void st8(bf16_t* p, const float (&f)[8]) {
    u32x4 w; w.x = cvt_pk_bf16(f[0], f[1]); w.y = cvt_pk_bf16(f[2], f[3]); w.z = cvt_pk_bf16(f[4], f[5]); w.w = cvt_pk_bf16(f[6], f[7]);
    *(u32x4*)p = w;
}
__device__ __forceinline__ float sigmoidf_(float a) { return __builtin_amdgcn_rcpf(1.0f + __expf(-a)); }
__device__ __forceinline__ float siluf_(float a) { return a * sigmoidf_(a); }
__device__ __forceinline__ float gelu_tanh_(float v) { const float u = 0.7978845608028654f * (v + 0.044715f * v * v * v); return v * sigmoidf_(2.0f * u); }
__device__ __forceinline__ int fresh_lane() { int l; asm volatile("v_mbcnt_lo_u32_b32 %0, -1, 0\n\tv_mbcnt_hi_u32_b32 %0, -1, %0" : "=v"(l)); return l; }
__device__ __forceinline__ float shfl_xor_l(float v, int o, int lane) { return __int_as_float(__builtin_amdgcn_ds_bpermute((lane ^ o) << 2, __float_as_int(v))); }
__device__ __forceinline__ float wave_sum(float v, int lane) {
#pragma unroll
    for (int o = 1; o < 64; o <<= 1) v += shfl_xor_l(v, o, lane);
    return v;
}

namespace pg8 {
constexpr int BM = 256, BK = 64, HALF = 128, HTB = HALF * BK * 2, STAGE_BYTES = 8 * HTB, NXCD = 8, WGM = 4;
__host__ __device__ __forceinline__ int lds_byte(int r, int c) { const int st = (r >> 4) * 2 + (c >> 5), rr = r & 15, cc = c & 31, ob = rr * 64 + cc * 2; return st * 1024 + (ob ^ (((ob >> 9) & 1) << 5)); }
__host__ __device__ __forceinline__ void stage_rc(int b, int& R, int& C) { const int st = b / 1024, sb = b % 1024, swz = sb ^ (((sb >> 9) & 1) << 5); R = (st >> 1) * 16 + swz / 64; C = (st & 1) * 32 + (swz % 64) / 2; }
__host__ __device__ __forceinline__ int perm32(int rho) { const int n = rho >> 4, i = rho & 15; return 8 * (i >> 2) + 4 * n + (i & 3); }

struct Unit { int pm, pn; };
struct Gemm { const bf16_t* A; const bf16_t* Bt; int K, lda, ldb; };

struct StaticOrder {
    int nM, nN, nwg, G, c;
    __device__ void init(int M, int N, int G_, int c_) { nM = M / BM; nN = N / BM; nwg = nM * nN; G = G_; c = c_; }
    __device__ bool next(int i, Unit& u) const {
        const long L = (long)i * G + c; if (L >= nwg) return false;
        int wgid = (int)L; { const int q = nwg / NXCD, r = nwg % NXCD, xcd = wgid % NXCD, off = wgid / NXCD; wgid = (xcd < r ? xcd * (q + 1) : r * (q + 1) + (xcd - r) * q) + off; }
        const int nig = WGM * nN, gid = wgid / nig, fm = gid * WGM;
        u.pm = fm + ((wgid % nig) % WGM); u.pn = (wgid % nig) / WGM; return true;
    }
};
struct RoundOrder {
    int xcd, slot;
    __device__ bool next(int i, Unit& u) const { if (i >= 4) return false; u.pm = i * 64 + xcd * 8 + (slot >> 2); u.pn = slot & 3; return true; }
};
struct PairOrder {
    int pm, pn0;
    __device__ bool next(int i, Unit& u) const { if (i >= 2) return false; u.pm = pm; u.pn = pn0 + i; return true; }
};
struct OneUnit {
    int pm, pn; bool valid;
    __device__ bool next(int i, Unit& u) const { if (i != 0 || !valid) return false; u.pm = pm; u.pn = pn; return true; }
};

template <class Epi, class Sched, bool ALIGN_EPI>
__device__ __forceinline__ void gemm_phase(LAS unsigned char* lds, const Gemm g, const Sched& S, const Epi& E, int wid) {
    asm volatile("" : "+s"(wid));
    const int wr = wid >> 2, wc = wid & 3; int fr = 0, fq = 0;
    const int K = g.K, nt = K / BK;
    unsigned voffA[2], voffB[2]; int aoff, boff;
#define PG8_LANE_CONSTS() do { const int lane_ = fresh_lane(), tid_ = wid * 64 + lane_; fr = lane_ & 15; fq = lane_ >> 4; \
        _Pragma("unroll") for (int i = 0; i < 2; ++i) { int R, C; stage_rc(tid_ * 16 + i * 8192, R, C); const int Rb = Epi::PERM ? ((R & ~31) + perm32(R & 31)) : R; \
            voffA[i] = (unsigned)(R * g.lda + C) * 2u; voffB[i] = (unsigned)(Rb * g.ldb + C) * 2u; } \
        aoff = lds_byte(wr * 64 + fr, fq * 8); boff = lds_byte(wc * 32 + fr, fq * 8); } while (0)
    PG8_LANE_CONSTS();
    const size_t kstep = (size_t)(BK * 2);
    const size_t hstepA = (size_t)HALF * g.lda * 2, hstepB = (size_t)HALF * g.ldb * 2;
    const size_t tstepA = 2 * hstepA, tstepB = 2 * hstepB;
    const unsigned ldsw = (unsigned)wid * 1024u;
#define PG8_SA(b, h) (((b) * 2 + (h)) * HTB)
#define PG8_SB(b, h) ((4 + (b) * 2 + (h)) * HTB)
#define PG8_STAGE(bufoff, gbase, voff) do { _Pragma("unroll") for (int _i = 0; _i < 2; ++_i) \
        __builtin_amdgcn_global_load_lds((const unsigned*)((const char*)(gbase) + (voff)[_i]), (LAS unsigned*)(lds + (bufoff) + ldsw + _i * 8192), 16, 0, 0); } while (0)
#define PG8_LDA(dst, b, h) do { _Pragma("unroll") for (int m = 0; m < 4; ++m) _Pragma("unroll") for (int k = 0; k < 2; ++k) dst[m][k] = *(const LAS bf16x8*)(lds + PG8_SA(b, h) + aoff + m * 2048 + k * 1024); } while (0)
#define PG8_LDB(dst, b, h) do { _Pragma("unroll") for (int n = 0; n < 2; ++n) _Pragma("unroll") for (int k = 0; k < 2; ++k) dst[n][k] = *(const LAS bf16x8*)(lds + PG8_SB(b, h) + boff + n * 2048 + k * 1024); } while (0)
#define PG8_MMA(ai, bj, At, Bt) do { __builtin_amdgcn_s_setprio(1); _Pragma("unroll") for (int m = 0; m < 4; ++m) _Pragma("unroll") for (int n = 0; n < 2; ++n) _Pragma("unroll") for (int k = 0; k < 2; ++k) \
        acc[ai][bj][m][n] = __builtin_amdgcn_mfma_f32_16x16x32_bf16(Bt[n][k], At[m][k], acc[ai][bj][m][n], 0, 0, 0); __builtin_amdgcn_s_setprio(0); } while (0)
#define PG8_WAIT_V(n) asm volatile("s_waitcnt vmcnt(" #n ")" ::: "memory")
#define PG8_WAIT_L(n) asm volatile("s_waitcnt lgkmcnt(" #n ")" ::: "memory")
#define PG8_BAR __builtin_amdgcn_s_barrier()
#define PG8_SCHED __builtin_amdgcn_sched_barrier(0)
    Unit cur, nxt; int ui = 0;
    if (!S.next(0, cur)) return;
    f32x4 acc[2][2][4][2];
#pragma unroll
    for (int a = 0; a < 2; ++a)
#pragma unroll
        for (int b = 0; b < 2; ++b)
#pragma unroll
            for (int m = 0; m < 4; ++m)
#pragma unroll
                for (int n = 0; n < 2; ++n) acc[a][b][m][n] = (f32x4){0.f, 0.f, 0.f, 0.f};
    bf16x8 At[4][2], B0[2][2], B1[2][2];
    const char* cA = (const char*)g.A + (size_t)cur.pm * tstepA; const char* cB = (const char*)g.Bt + (size_t)cur.pn * tstepB;
    PG8_STAGE(PG8_SB(0, 0), cB, voffB); PG8_STAGE(PG8_SB(0, 1), cB + hstepB, voffB); PG8_STAGE(PG8_SA(0, 0), cA, voffA); PG8_STAGE(PG8_SA(0, 1), cA + hstepA, voffA);
    if (wr == 1) PG8_BAR;
    PG8_WAIT_V(2); PG8_BAR;
    PG8_STAGE(PG8_SB(1, 0), cB + kstep, voffB); PG8_STAGE(PG8_SA(1, 0), cA + kstep, voffA); PG8_STAGE(PG8_SB(1, 1), cB + hstepB + kstep, voffB);
    PG8_WAIT_V(6); PG8_BAR;
    for (;;) {
        PG8_LANE_CONSTS();
        const bool has_next = S.next(ui + 1, nxt);
        const char* nA = has_next ? (const char*)g.A + (size_t)nxt.pm * tstepA : cA; const char* nB = has_next ? (const char*)g.Bt + (size_t)nxt.pn * tstepB : cB;
        for (int t = 0; t < nt; t += 2) {
            const bool last = (t == nt - 2);
            const char* a1 = cA + (size_t)(t + 1) * kstep;
            const char* a2 = last ? nA : cA + (size_t)(t + 2) * kstep; const char* b2 = last ? nB : cB + (size_t)(t + 2) * kstep;
            const char* a3 = a2 + kstep; const char* b3 = b2 + kstep;
            PG8_LDB(B0, 0, 0); PG8_LDB(B1, 0, 1); PG8_SCHED; PG8_LDA(At, 0, 0); PG8_STAGE(PG8_SA(1, 1), a1 + hstepA, voffA);
            PG8_WAIT_V(8); PG8_WAIT_L(0); PG8_BAR; PG8_MMA(0, 0, At, B0); PG8_MMA(0, 1, At, B1); PG8_BAR; PG8_SCHED;
            PG8_LDA(At, 0, 1); PG8_STAGE(PG8_SB(0, 0), b2, voffB); PG8_STAGE(PG8_SB(0, 1), b2 + hstepB, voffB); PG8_STAGE(PG8_SA(0, 0), a2, voffA);
            PG8_WAIT_V(8); PG8_WAIT_L(0); PG8_BAR; PG8_MMA(1, 0, At, B0); PG8_MMA(1, 1, At, B1); PG8_BAR; PG8_SCHED;
            PG8_LDB(B0, 1, 0); PG8_LDB(B1, 1, 1); PG8_SCHED; PG8_LDA(At, 1, 0); PG8_STAGE(PG8_SA(0, 1), a2 + hstepA, voffA);
            PG8_WAIT_V(8); PG8_WAIT_L(0); PG8_BAR; PG8_MMA(0, 0, At, B0); PG8_MMA(0, 1, At, B1); PG8_BAR; PG8_SCHED;
            PG8_LDA(At, 1, 1); PG8_STAGE(PG8_SB(1, 0), b3, voffB); PG8_STAGE(PG8_SB(1, 1), b3 + hstepB, voffB); PG8_STAGE(PG8_SA(1, 0), a3, voffA);
            PG8_WAIT_V(8); PG8_WAIT_L(0); PG8_BAR; PG8_MMA(1, 0, At, B0); PG8_MMA(1, 1, At, B1); PG8_BAR; PG8_SCHED;
        }
        if constexpr (ALIGN_EPI) { if (wr == 0) PG8_BAR; }
        if constexpr (!Epi::AFTER_DRAIN) { E(acc, cur, wr, wc, fr, fq); }
        if (!has_next) break;
#pragma unroll
        for (int a = 0; a < 2; ++a)
#pragma unroll
            for (int b = 0; b < 2; ++b)
#pragma unroll
                for (int m = 0; m < 4; ++m)
#pragma unroll
                    for (int n = 0; n < 2; ++n) acc[a][b][m][n] = (f32x4){0.f, 0.f, 0.f, 0.f};
        cur = nxt; cA = nA; cB = nB; ++ui;
        if constexpr (ALIGN_EPI) { if (wr == 1) PG8_BAR; }
    }
    PG8_WAIT_V(0);
    if constexpr (!ALIGN_EPI) { if (wr == 0) PG8_BAR; }
    PG8_BAR;
    static_assert(!Epi::AFTER_DRAIN, "all epilogues run inline");
#undef PG8_LANE_CONSTS
#undef PG8_SA
#undef PG8_SB
#undef PG8_STAGE
#undef PG8_LDA
#undef PG8_LDB
#undef PG8_MMA
#undef PG8_WAIT_V
#undef PG8_WAIT_L
#undef PG8_BAR
#undef PG8_SCHED
}


struct EpiZ {
    static constexpr bool PERM = true, AFTER_DRAIN = false;
    bf16_t* zmain; bf16_t* apr; const float* bias;
    __device__ __forceinline__ void operator()(const f32x4 (&acc)[2][2][4][2], const Unit& u, int wr, int wc, int fr_, int fq_) const {
        const int ln_ = fresh_lane(), fr = ln_ & 15, fq = ln_ >> 4;
        int row0 = u.pm * BM + wr * 64 + fr, cl = wc * 32 + 8 * fq; asm volatile("" : "+v"(row0));
        const int pn = u.pn;
        if (pn == 2 || pn == 3 || pn == 6) {
            const int sbase = pn == 2 ? 256 : (pn == 3 ? 768 : 1536), obase = pn == 2 ? 256 : 512;
#pragma unroll
            for (int bj = 0; bj < 2; ++bj) {
                const int c = bj * HALF + cl;
                const f32x4 b0 = *(const f32x4*)(bias + sbase + c), b1 = *(const f32x4*)(bias + sbase + c + 4);
#pragma unroll
                for (int ai = 0; ai < 2; ++ai)
#pragma unroll
                    for (int m = 0; m < 4; ++m) {
                        const int row = row0 + ai * HALF + m * 16;
                        const f32x4 v0 = acc[ai][bj][m][0] + b0, v1 = acc[ai][bj][m][1] + b1;
                        u32x4 w; w.x = cvt_pk_bf16(v0[0], v0[1]); w.y = cvt_pk_bf16(v0[2], v0[3]); w.z = cvt_pk_bf16(v1[0], v1[1]); w.w = cvt_pk_bf16(v1[2], v1[3]);
                        if (pn != 6) *(u32x4*)(zmain + (size_t)row * ZW + obase + c) = w;
                        else { const int gq = c >> 4, h0 = c & 15;
                            *(u32x4*)(apr + ((size_t)(gq * NBC + (row >> 5)) * KSSM + (row & 31) * 16 + h0)) = w; }
                    }
            }
        } else {
            const bool glu = pn >= 4; const int hc = (pn & 1) * HALF + cl;
            const int sa = glu ? 1024 : 0, sb = glu ? 1280 : 512, obase = glu ? 768 : 0;
            const f32x4 a0 = *(const f32x4*)(bias + sa + hc), a1 = *(const f32x4*)(bias + sa + hc + 4), c0 = *(const f32x4*)(bias + sb + hc), c1 = *(const f32x4*)(bias + sb + hc + 4);
#pragma unroll
            for (int ai = 0; ai < 2; ++ai)
#pragma unroll
                for (int m = 0; m < 4; ++m) {
                    const int row = row0 + ai * HALF + m * 16;
                    const f32x4 x0 = acc[ai][0][m][0] + a0, x1 = acc[ai][0][m][1] + a1, y0 = acc[ai][1][m][0] + c0, y1 = acc[ai][1][m][1] + c1;
                    float o[8];
                    if (glu) { o[0] = x0[0] * sigmoidf_(y0[0]); o[1] = x0[1] * sigmoidf_(y0[1]); o[2] = x0[2] * sigmoidf_(y0[2]); o[3] = x0[3] * sigmoidf_(y0[3]);
                               o[4] = x1[0] * sigmoidf_(y1[0]); o[5] = x1[1] * sigmoidf_(y1[1]); o[6] = x1[2] * sigmoidf_(y1[2]); o[7] = x1[3] * sigmoidf_(y1[3]); }
                    else { o[0] = x0[0] * y0[0]; o[1] = x0[1] * y0[1]; o[2] = x0[2] * y0[2]; o[3] = x0[3] * y0[3]; o[4] = x1[0] * y1[0]; o[5] = x1[1] * y1[1]; o[6] = x1[2] * y1[2]; o[7] = x1[3] * y1[3]; }
                    st8(zmain + (size_t)row * ZW + obase + hc, o);
                }
        }
    }
};
struct EpiStates {
    static constexpr bool PERM = false, AFTER_DRAIN = false;
    float* S;
    __device__ __forceinline__ void operator()(const f32x4 (&acc)[2][2][4][2], const Unit& u, int wr, int wc, int fr_, int fq_) const {
        const int ln_ = fresh_lane(), fr = ln_ & 15, fq = ln_ >> 4;
        int row0 = u.pm * BM + wr * 64 + fr, c0 = wc * 32 + 4 * fq; asm volatile("" : "+v"(row0));
#pragma unroll
        for (int ai = 0; ai < 2; ++ai)
#pragma unroll
            for (int m = 0; m < 4; ++m)
#pragma unroll
                for (int n = 0; n < 2; ++n) *(f32x4*)(S + (size_t)(row0 + ai * HALF + m * 16) * 128 + c0 + n * 16) = acc[ai][0][m][n];
    }
};
struct EpiSsmOut {
    static constexpr bool PERM = true, AFTER_DRAIN = false;
    bf16_t* yg;
    __device__ __forceinline__ void operator()(const f32x4 (&acc)[2][2][4][2], const Unit& u, int wr, int wc, int fr_, int fq_) const {
        const int ln_ = fresh_lane(), fr = ln_ & 15, fq = ln_ >> 4;
        const int gq = u.pn >> 1; int R0 = u.pm * BM + wr * 64 + fr; asm volatile("" : "+v"(R0));
#pragma unroll
        for (int bj = 0; bj < 2; ++bj) {
            const int lc = (u.pn & 1) * 256 + bj * HALF + wc * 32 + 8 * fq, t = lc >> 4, h0 = lc & 15;
#pragma unroll
            for (int ai = 0; ai < 2; ++ai)
#pragma unroll
                for (int m = 0; m < 4; ++m) {
                    const int R = R0 + ai * HALF + m * 16, bc = R & (NBC - 1);
                    const f32x4 v0 = acc[ai][bj][m][0], v1 = acc[ai][bj][m][1];
                    u32x4 w; w.x = cvt_pk_bf16(gelu_tanh_(v0[0]), gelu_tanh_(v0[1])); w.y = cvt_pk_bf16(gelu_tanh_(v0[2]), gelu_tanh_(v0[3]));
                    w.z = cvt_pk_bf16(gelu_tanh_(v1[0]), gelu_tanh_(v1[1])); w.w = cvt_pk_bf16(gelu_tanh_(v1[2]), gelu_tanh_(v1[3]));
                    *(u32x4*)(yg + (size_t)(bc * CT + t) * 256 + gq * 16 + h0) = w;
                }
        }
    }
};
struct EpiGlu {
    static constexpr bool PERM = true, AFTER_DRAIN = false;
    const bf16_t* yg; bf16_t* ymix; const float* bias;
    __device__ __forceinline__ void operator()(const f32x4 (&acc)[2][2][4][2], const Unit& u, int wr, int wc, int fr_, int fq_) const {
        const int ln_ = fresh_lane(), fr = ln_ & 15, fq = ln_ >> 4;
        int row0 = u.pm * BM + wr * 64 + fr, cl = wc * 32 + 8 * fq; asm volatile("" : "+v"(row0));
        u32x4 yv[2][2][4];
#pragma unroll
        for (int bj = 0; bj < 2; ++bj)
#pragma unroll
            for (int ai = 0; ai < 2; ++ai)
#pragma unroll
                for (int m = 0; m < 4; ++m) yv[bj][ai][m] = *(const u32x4*)(yg + (size_t)(row0 + ai * HALF + m * 16) * 256 + bj * HALF + cl);
#pragma unroll
        for (int bj = 0; bj < 2; ++bj) {
            const int c = bj * HALF + cl;
            const f32x4 b0 = *(const f32x4*)(bias + c), b1 = *(const f32x4*)(bias + c + 4);
#pragma unroll
            for (int ai = 0; ai < 2; ++ai)
#pragma unroll
                for (int m = 0; m < 4; ++m) {
                    const int row = row0 + ai * HALF + m * 16; const u32x4 w = yv[bj][ai][m];
                    const f32x4 t0 = (acc[ai][bj][m][0] + b0) * (-1.4426950408889634f), t1 = (acc[ai][bj][m][1] + b1) * (-1.4426950408889634f);
                    const f32x4 d0 = (f32x4){__builtin_amdgcn_exp2f(t0[0]), __builtin_amdgcn_exp2f(t0[1]), __builtin_amdgcn_exp2f(t0[2]), __builtin_amdgcn_exp2f(t0[3])} + 1.0f;
                    const f32x4 d1 = (f32x4){__builtin_amdgcn_exp2f(t1[0]), __builtin_amdgcn_exp2f(t1[1]), __builtin_amdgcn_exp2f(t1[2]), __builtin_amdgcn_exp2f(t1[3])} + 1.0f;
                    const f32x4 y0 = (f32x4){__uint_as_float(w.x << 16), __uint_as_float(w.x & 0xffff0000u), __uint_as_float(w.y << 16), __uint_as_float(w.y & 0xffff0000u)};
                    const f32x4 y1 = (f32x4){__uint_as_float(w.z << 16), __uint_as_float(w.z & 0xffff0000u), __uint_as_float(w.w << 16), __uint_as_float(w.w & 0xffff0000u)};
                    const f32x4 o0 = y0 * (f32x4){__builtin_amdgcn_rcpf(d0[0]), __builtin_amdgcn_rcpf(d0[1]), __builtin_amdgcn_rcpf(d0[2]), __builtin_amdgcn_rcpf(d0[3])};
                    const f32x4 o1 = y1 * (f32x4){__builtin_amdgcn_rcpf(d1[0]), __builtin_amdgcn_rcpf(d1[1]), __builtin_amdgcn_rcpf(d1[2]), __builtin_amdgcn_rcpf(d1[3])};
                    u32x4 ow; ow.x = cvt_pk_bf16(o0[0], o0[1]); ow.y = cvt_pk_bf16(o0[2], o0[3]); ow.z = cvt_pk_bf16(o1[0], o1[1]); ow.w = cvt_pk_bf16(o1[2], o1[3]);
                    *(u32x4*)(ymix + (size_t)row * DM + 768 + c) = ow;
                }
            asm volatile("" ::: "memory");
        }
    }
};
struct EpiSwiGlu {
    static constexpr bool PERM = true, AFTER_DRAIN = false;
    bf16_t* hid;
    __device__ __forceinline__ void operator()(const f32x4 (&acc)[2][2][4][2], const Unit& u, int wr, int wc, int fr_, int fq_) const {
        const int ln_ = fresh_lane(), fr = ln_ & 15, fq = ln_ >> 4;
        int row0 = u.pm * BM + wr * 64 + fr, c = u.pn * HALF + wc * 32 + 8 * fq; asm volatile("" : "+v"(row0));
#pragma unroll
        for (int ai = 0; ai < 2; ++ai)
#pragma unroll
            for (int m = 0; m < 4; ++m) {
                const int row = row0 + ai * HALF + m * 16;
                const f32x4 g0 = acc[ai][0][m][0], g1 = acc[ai][0][m][1], u0 = acc[ai][1][m][0], u1 = acc[ai][1][m][1];
                const f32x4 t0 = g0 * (-1.4426950408889634f), t1 = g1 * (-1.4426950408889634f);
                const f32x4 d0 = (f32x4){__builtin_amdgcn_exp2f(t0[0]), __builtin_amdgcn_exp2f(t0[1]), __builtin_amdgcn_exp2f(t0[2]), __builtin_amdgcn_exp2f(t0[3])} + 1.0f;
                const f32x4 d1 = (f32x4){__builtin_amdgcn_exp2f(t1[0]), __builtin_amdgcn_exp2f(t1[1]), __builtin_amdgcn_exp2f(t1[2]), __builtin_amdgcn_exp2f(t1[3])} + 1.0f;
                const f32x4 r0 = (f32x4){__builtin_amdgcn_rcpf(d0[0]), __builtin_amdgcn_rcpf(d0[1]), __builtin_amdgcn_rcpf(d0[2]), __builtin_amdgcn_rcpf(d0[3])};
                const f32x4 r1 = (f32x4){__builtin_amdgcn_rcpf(d1[0]), __builtin_amdgcn_rcpf(d1[1]), __builtin_amdgcn_rcpf(d1[2]), __builtin_amdgcn_rcpf(d1[3])};
                const f32x4 o0 = (g0 * r0) * u0, o1 = (g1 * r1) * u1;
                u32x4 w; w.x = cvt_pk_bf16(o0[0], o0[1]); w.y = cvt_pk_bf16(o0[2], o0[3]); w.z = cvt_pk_bf16(o1[0], o1[1]); w.w = cvt_pk_bf16(o1[2], o1[3]);
                __builtin_nontemporal_store(w, (u32x4*)(hid + (size_t)row * FF + c));
            }
    }
};
struct EpiLn {
    static constexpr bool PERM = true, AFTER_DRAIN = false;
    float* xout; bf16_t* h; const float* tab;
    unsigned long long* xbuf; unsigned* tmo; unsigned tag; LAS unsigned char* xl;
    __device__ __forceinline__ void operator()(f32x4 (&acc)[2][2][4][2], const Unit& u, int wr, int wc, int fr_, int fq_) const {
        const int wid = wr * 4 + wc; LAS unsigned char* lds = xl;
        const int lane = fresh_lane(), fr = lane & 15, fq = lane >> 4;
        const float* tb = tab + (u.pm >> 5) * 5120;
        const int col0 = u.pn * BM + wc * 32 + 8 * fq;
        int rloc = wr * 64 + fr; asm volatile("" : "+v"(rloc));
#pragma unroll
        for (int bj = 0; bj < 2; ++bj) {
            f32x4 gv[2], pa[2], pb[2]; u32x4 hv[2][4];
            const int colb = col0 + bj * HALF;
#pragma unroll
            for (int n = 0; n < 2; ++n) { gv[n] = *(const f32x4*)(tb + colb + 4 * n); pa[n] = *(const f32x4*)(tb + 1024 + colb + 4 * n); pb[n] = *(const f32x4*)(tb + 2048 + colb + 4 * n); }
#pragma unroll
            for (int ai = 0; ai < 2; ++ai)
#pragma unroll
                for (int m = 0; m < 4; ++m) hv[ai][m] = *(const u32x4*)(h + (size_t)(u.pm * BM + rloc + ai * HALF + m * 16) * DM + colb);
#pragma unroll
            for (int ai = 0; ai < 2; ++ai)
#pragma unroll
                for (int m = 0; m < 4; ++m) {
                    const u32x4 w = hv[ai][m];
                    const f32x4 hx0 = (f32x4){__uint_as_float(w.x << 16), __uint_as_float(w.x & 0xffff0000u), __uint_as_float(w.y << 16), __uint_as_float(w.y & 0xffff0000u)};
                    const f32x4 hx1 = (f32x4){__uint_as_float(w.z << 16), __uint_as_float(w.z & 0xffff0000u), __uint_as_float(w.w << 16), __uint_as_float(w.w & 0xffff0000u)};
                    acc[ai][bj][m][0] = hx0 * pa[0] + (gv[0] * acc[ai][bj][m][0] - pb[0]);
                    acc[ai][bj][m][1] = hx1 * pa[1] + (gv[1] * acc[ai][bj][m][1] - pb[1]);
                    asm volatile("" : "+v"(acc[ai][bj][m][0]), "+v"(acc[ai][bj][m][1]));
                }
            asm volatile("" ::: "memory");
        }
        f32x4 oa[2][2], ob[2][2];
#pragma unroll
        for (int bj = 0; bj < 2; ++bj)
#pragma unroll
            for (int n = 0; n < 2; ++n) {
                const int col = col0 + bj * HALF + 4 * n;
                oa[bj][n] = *(const f32x4*)(tb + 3072 + col); ob[bj][n] = *(const f32x4*)(tb + 4096 + col);
            }
        LAS f32x2* P = (LAS f32x2*)lds;
        LAS f32x2* Sx = (LAS f32x2*)(lds + 8192);
#pragma unroll
        for (int ai = 0; ai < 2; ++ai)
#pragma unroll
            for (int m = 0; m < 4; ++m) {
                f32x4 s4 = (f32x4){0.f, 0.f, 0.f, 0.f}, q4 = s4;
#pragma unroll
                for (int bj = 0; bj < 2; ++bj)
#pragma unroll
                    for (int n = 0; n < 2; ++n) { const f32x4 v = acc[ai][bj][m][n]; s4 += v; q4 += v * v; }
                float s = (s4[0] + s4[1]) + (s4[2] + s4[3]), q = (q4[0] + q4[1]) + (q4[2] + q4[3]);
                s += shfl_xor_l(s, 16, lane); q += shfl_xor_l(q, 16, lane); s += shfl_xor_l(s, 32, lane); q += shfl_xor_l(q, 32, lane);
                if (fq == 0) P[(ai * HALF + rloc + m * 16) * 4 + wc] = (f32x2){s, q};
            }
        asm volatile("s_waitcnt lgkmcnt(0)" ::: "memory"); __builtin_amdgcn_s_barrier(); asm volatile("" ::: "memory");
        const int row = wid * 32 + (lane & 31);
        if (lane < 32) {
            const f32x2 a = P[row * 4 + 0], bq = P[row * 4 + 1], c = P[row * 4 + 2], d = P[row * 4 + 3];
            const float s1 = (a.x + bq.x) + (c.x + d.x), s2 = (a.y + bq.y) + (c.y + d.y);
            unsigned long long* slot = xbuf + (size_t)(u.pm * BM + row) * 4;
            __hip_atomic_store(slot + u.pn, ((unsigned long long)((__float_as_uint(s2) & ~7u) | tag) << 32) | __float_as_uint(s1), __ATOMIC_RELAXED, __HIP_MEMORY_SCOPE_AGENT);
            unsigned long long w0, w1, w2, w3; unsigned sp = 0;
            for (;;) {
                w0 = __hip_atomic_load(slot + 0, __ATOMIC_RELAXED, __HIP_MEMORY_SCOPE_AGENT); w1 = __hip_atomic_load(slot + 1, __ATOMIC_RELAXED, __HIP_MEMORY_SCOPE_AGENT);
                w2 = __hip_atomic_load(slot + 2, __ATOMIC_RELAXED, __HIP_MEMORY_SCOPE_AGENT); w3 = __hip_atomic_load(slot + 3, __ATOMIC_RELAXED, __HIP_MEMORY_SCOPE_AGENT);
                const unsigned t0 = (unsigned)(w0 >> 32) & 7u, t1 = (unsigned)(w1 >> 32) & 7u, t2 = (unsigned)(w2 >> 32) & 7u, t3 = (unsigned)(w3 >> 32) & 7u;
                if (t0 == tag && t1 == tag && t2 == tag && t3 == tag) break;
                if (++sp > (1u << 20)) { __hip_atomic_store(tmo, 1u, __ATOMIC_RELAXED, __HIP_MEMORY_SCOPE_AGENT); break; }
                __builtin_amdgcn_s_sleep(1);
            }
            const float T1 = (__uint_as_float((unsigned)w0) + __uint_as_float((unsigned)w1)) + (__uint_as_float((unsigned)w2) + __uint_as_float((unsigned)w3));
            const float T2 = (__uint_as_float((unsigned)(w0 >> 32) & ~7u) + __uint_as_float((unsigned)(w1 >> 32) & ~7u)) + (__uint_as_float((unsigned)(w2 >> 32) & ~7u) + __uint_as_float((unsigned)(w3 >> 32) & ~7u));
            const float mean = T1 * (1.0f / 1024.0f); float var = T2 * (1.0f / 1024.0f) - mean * mean; var = var > 0.f ? var : 0.f;
            Sx[row] = (f32x2){mean, __builtin_amdgcn_rsqf(var + LN_EPS)};
        }
        asm volatile("s_waitcnt lgkmcnt(0)" ::: "memory"); __builtin_amdgcn_s_barrier(); asm volatile("" ::: "memory");
        asm volatile("" : "+v"(rloc));
#pragma unroll
        for (int bj = 0; bj < 2; ++bj)
#pragma unroll
            for (int ai = 0; ai < 2; ++ai)
#pragma unroll
                for (int m = 0; m < 4; ++m) {
                    const int r = ai * HALF + rloc + m * 16; const f32x2 sr = Sx[r];
                    const size_t off = (size_t)(u.pm * BM + r) * DM + col0 + bj * HALF;
                    const f32x4 o0 = (acc[ai][bj][m][0] - sr.x) * sr.y * oa[bj][0] + ob[bj][0];
                    const f32x4 o1 = (acc[ai][bj][m][1] - sr.x) * sr.y * oa[bj][1] + ob[bj][1];
                    if (xout) { *(f32x4*)(xout + off) = o0; *(f32x4*)(xout + off + 4) = o1; }
                    else { u32x4 w; w.x = cvt_pk_bf16(o0[0], o0[1]); w.y = cvt_pk_bf16(o0[2], o0[3]); w.z = cvt_pk_bf16(o1[0], o1[1]); w.w = cvt_pk_bf16(o1[2], o1[3]); *(u32x4*)(h + off) = w; }
                }
    }
};
}

struct Args { const float* in[31]; float* out; unsigned char* ws; };
#define CAS __attribute__((address_space(4)))
__device__ __forceinline__ const CAS Args* fresh_args() { const CAS Args* p = (const CAS Args*)__builtin_amdgcn_kernarg_segment_ptr(); asm volatile("" : "+s"(p)); return p; }
#define PH_PTRS0 const int l_ = 0; PH_PTRS_(l_)
#define PH_PTRS PH_PTRS_(l)
#define PH_PTRS_(l) \
    const CAS Args* ka = fresh_args(); unsigned char* ws = ka->ws; \
    [[maybe_unused]] unsigned* ctl = (unsigned*)(ws + WS_CTL); [[maybe_unused]] float* mod = (float*)(ws + WS_MOD); \
    [[maybe_unused]] f32x2* pw = (f32x2*)(ws + WS_PW); [[maybe_unused]] f32x2* bbar = (f32x2*)(ws + WS_BBAR); [[maybe_unused]] float* Kk = (float*)(ws + WS_KK); \
    [[maybe_unused]] bf16_t* win_t = (bf16_t*)(ws + WS_WIN); [[maybe_unused]] bf16_t* wo_t = (bf16_t*)(ws + WS_WO); [[maybe_unused]] bf16_t* wgu_t = (bf16_t*)(ws + WS_WGU); \
    [[maybe_unused]] bf16_t* wdn_t = (bf16_t*)(ws + WS_WDN); [[maybe_unused]] bf16_t* wglu_t = (bf16_t*)(ws + WS_WGLU); \
    [[maybe_unused]] bf16_t* btout = (bf16_t*)(ws + WS_BTOUT); [[maybe_unused]] bf16_t* w1m = (bf16_t*)(ws + WS_W1); \
    [[maybe_unused]] bf16_t* hmod = (bf16_t*)(ws + WS_HMOD); [[maybe_unused]] bf16_t* zmain = (bf16_t*)(ws + WS_ZMAIN); [[maybe_unused]] bf16_t* apr = (bf16_t*)(ws + WS_APR); \
    [[maybe_unused]] float* Sst = (float*)(ws + WS_S); [[maybe_unused]] bf16_t* yg = (bf16_t*)(ws + WS_YG); [[maybe_unused]] bf16_t* ymix = (bf16_t*)(ws + WS_YMIX); [[maybe_unused]] bf16_t* hid = (bf16_t*)(ws + WS_HID); \
    [[maybe_unused]] float* xres = ka->out; [[maybe_unused]] const float* modl = mod + (size_t)l * 8 * 6144;

#define XB_TMO      128
#define XB_XCNT(j)  (256  + 64 * (j))
#define XB_XSUB(j)  (1280 + 64 * (j))
#define XB_XGEN(j)  (2304 + 64 * (j))
#define XB_TOP      3328
#define XB_TOPGEN   3392
#define XB_SPIN_CAP (1u << 18)
constexpr int XB_LDS_OFF = 131072 + 14336;
__device__ __forceinline__ unsigned xb_ld(unsigned* p)              { return __hip_atomic_load(p, __ATOMIC_RELAXED, __HIP_MEMORY_SCOPE_AGENT); }
__device__ __forceinline__ unsigned xb_add(unsigned* p, unsigned v) { return __hip_atomic_fetch_add(p, v, __ATOMIC_RELAXED, __HIP_MEMORY_SCOPE_AGENT); }
__device__ __forceinline__ unsigned xb_xcc_id() { return (unsigned)__builtin_amdgcn_s_getreg((3 << 11) | 20) & 0xFu; }
#define XB_SPIN(cond, bar) do { unsigned _sp = 0; while (cond) { __builtin_amdgcn_s_sleep(1); \
    if ((++_sp & 255u) == 0u) { if (xb_ld(&(bar)[XB_TMO])) break; if (_sp > XB_SPIN_CAP) { atomicAdd(&(bar)[XB_TMO], 1u); break; } } } } while (0)
__device__ __forceinline__ void xcd_barrier_complete(unsigned* bar, unsigned x, unsigned& nloc, unsigned& nx) {
    const unsigned G = (unsigned)GRID;
    unsigned sum, cnt, mine, sp = 0u;
    for (;;) {
        sum = 0u; cnt = 0u; mine = 0u;
#pragma unroll
        for (unsigned j = 0; j < 16; ++j) { const unsigned c = xb_ld(&bar[XB_XCNT(j)]); sum += c; cnt += (c > 0u) ? 1u : 0u; mine = (j == x) ? c : mine; }
        if (sum == G) break;
        __builtin_amdgcn_s_sleep(1);
        if ((++sp & 255u) == 0u) { if (xb_ld(&bar[XB_TMO])) break; if (sp > XB_SPIN_CAP) { atomicAdd(&bar[XB_TMO], 1u); break; } }
    }
    nloc = mine > 0u ? mine : 1u; nx = cnt > 0u ? cnt : 1u;
}
__device__ __forceinline__ void grid_bar(int wave, unsigned char* smem) {
    asm volatile("s_waitcnt vmcnt(0)" ::: "memory");
    __syncthreads();
    asm volatile("" : "+s"(wave));
    if (wave == 0 && fresh_lane() == 0) {
        const CAS Args* ka = fresh_args(); unsigned* bar = (unsigned*)(ka->ws + WS_CTL) + CW_XB;
        volatile LAS unsigned* st = (volatile LAS unsigned*)((LAS unsigned char*)smem + XB_LDS_OFF);
        const unsigned x = xb_xcc_id();
        __builtin_amdgcn_s_waitcnt(0);
        unsigned nloc = st[0], nx = st[1];
        if (nloc == 0u) { xcd_barrier_complete(bar, x, nloc, nx); st[0] = nloc; st[1] = nx; }
        const unsigned old = xb_add(&bar[XB_XSUB(x)], 1u);
        const unsigned gen = old / nloc;
        if (old + 1u == (gen + 1u) * nloc) {
            __builtin_amdgcn_fence(__ATOMIC_RELEASE, "agent");
            asm volatile("s_waitcnt vmcnt(0)" ::: "memory");
            const unsigned og = xb_add(&bar[XB_TOP], 1u);
            const unsigned tg = og / nx;
            if (og + 1u == (tg + 1u) * nx) xb_add(&bar[XB_TOPGEN], 1u);
            else XB_SPIN(xb_ld(&bar[XB_TOPGEN]) == tg, bar);
            __builtin_amdgcn_fence(__ATOMIC_ACQUIRE, "agent");
            xb_add(&bar[XB_XGEN(x)], 1u);
            asm volatile("s_waitcnt vmcnt(0)" ::: "memory");
        } else {
            XB_SPIN(xb_ld(&bar[XB_XGEN(x)]) == gen, bar);
            __builtin_amdgcn_fence(__ATOMIC_ACQUIRE, "agent");
            asm volatile("s_waitcnt vmcnt(0)" ::: "memory");
        }
    }
    __syncthreads();
}
#define PH_T0() unsigned long long ph_t0_ = 0; if (AMP_MASK) ph_t0_ = __builtin_amdgcn_s_memrealtime()
#define PH_AMP(i) do { if (AMP_MASK & (1u << (i))) { const unsigned long long t1_ = __builtin_amdgcn_s_memrealtime(); while (__builtin_amdgcn_s_memrealtime() - t1_ < t1_ - ph_t0_) __builtin_amdgcn_s_sleep(8); } } while (0)
__device__ __forceinline__ void transpose_item(const float* W, int K, int N, bf16_t* WT, int mode, float* scr, int item, int lane) {
    const int nblk = N / 32, kb = item / nblk, nb = item % nblk, k0 = 64 * kb, n0 = 32 * nb;
    int drow0 = mode == 0 ? n0 : (256 * (n0 >> 7) + (n0 & 127) + (mode == 2 ? 128 : 0));
    if (mode == 3) {
        const int seg = n0 >> 8, c = n0 & 255, pr = 256 * (c >> 7) + (c & 127);
        drow0 = seg == 0 ? pr : seg == 1 ? 512 + c : seg == 2 ? pr + 128 : seg == 3 ? 768 + c : seg == 4 ? 1024 + pr : seg == 5 ? 1024 + pr + 128 : n0;
    }
    float wv_[32];
#pragma unroll
    for (int i = 0; i < 32; ++i) wv_[i] = W[(size_t)(k0 + 2 * i + (lane >> 5)) * N + n0 + (lane & 31)];
#pragma unroll
    for (int i = 0; i < 32; ++i) scr[(2 * i + (lane >> 5)) * 33 + (lane & 31)] = wv_[i];
    asm volatile("s_waitcnt lgkmcnt(0)" ::: "memory");
    const int c = lane & 7;
#pragma unroll
    for (int j = 0; j < 4; ++j) { const int n = (lane >> 3) + 8 * j; const float* s = scr + (8 * c) * 33 + n;
        u32x4 o; o.x = cvt_pk_bf16(s[0 * 33], s[1 * 33]); o.y = cvt_pk_bf16(s[2 * 33], s[3 * 33]); o.z = cvt_pk_bf16(s[4 * 33], s[5 * 33]); o.w = cvt_pk_bf16(s[6 * 33], s[7 * 33]);
        *(u32x4*)(WT + (size_t)(drow0 + n) * K + k0 + 8 * c) = o; }
    asm volatile("s_waitcnt lgkmcnt(0)" ::: "memory");
}

__device__ __forceinline__ void fused_pool_item(const float* W, const float* poolw, const float* scale, bf16_t* WT, float* scr, int item, int lane) {
    const int K = DM, N = DM, nblk = N / 32, kb = item / nblk, nb = item % nblk, k0 = 64 * kb, n0 = 32 * nb;
    const int n = lane & 31, half = lane >> 5;
    float a[32];
#pragma unroll
    for (int i = 0; i < 32; ++i) a[i] = 0.f;
    for (int d = 0; d < 64; ++d) {
        const float wv = W[(size_t)(k0 + d) * N + n0 + n] * scale[d];
#pragma unroll
        for (int i = 0; i < 32; ++i) a[i] += poolw[(2 * i + half) * 64 + d] * wv;
    }
#pragma unroll
    for (int i = 0; i < 32; ++i) scr[(2 * i + half) * 33 + n] = a[i];
    asm volatile("s_waitcnt lgkmcnt(0)" ::: "memory");
    const int c = lane & 7;
#pragma unroll
    for (int j = 0; j < 4; ++j) { const int nn = (lane >> 3) + 8 * j; const float* s = scr + (8 * c) * 33 + nn;
        u32x4 o; o.x = cvt_pk_bf16(s[0 * 33], s[1 * 33]); o.y = cvt_pk_bf16(s[2 * 33], s[3 * 33]); o.z = cvt_pk_bf16(s[4 * 33], s[5 * 33]); o.w = cvt_pk_bf16(s[6 * 33], s[7 * 33]);
        *(u32x4*)(WT + (size_t)(n0 + nn) * K + k0 + 8 * c) = o; }
    asm volatile("s_waitcnt lgkmcnt(0)" ::: "memory");
}

__device__ __forceinline__ void unpack8(const u32x4 w, float (&f)[8]) {
    f[0] = __uint_as_float(w.x << 16); f[1] = __uint_as_float(w.x & 0xffff0000u); f[2] = __uint_as_float(w.y << 16); f[3] = __uint_as_float(w.y & 0xffff0000u);
    f[4] = __uint_as_float(w.z << 16); f[5] = __uint_as_float(w.z & 0xffff0000u); f[6] = __uint_as_float(w.w << 16); f[7] = __uint_as_float(w.w & 0xffff0000u);
}
struct MixRaw { u32x4 ra[2][4], rb[3], rc[4]; };
__device__ __forceinline__ void mix_load(MixRaw& R, int item, const bf16_t* zm, int tq, int ch) {
    const int b = item >> 8, s0 = (item & 255) * 32; const size_t row0 = (size_t)b * SEQ + s0;
    const u32x4 zero4 = (u32x4){0u, 0u, 0u, 0u};
#pragma unroll
    for (int it = 0; it < 2; ++it) { const int tk = tq + 16 * it, s = s0 + tk; const size_t row = row0 + tk;
        R.ra[it][0] = *(const u32x4*)(zm + row * ZW + 256 + ch);
#pragma unroll
        for (int k = 0; k < 3; ++k) R.ra[it][1 + k] = (s - 2 + k >= 0) ? *(const u32x4*)(zm + (row - 2 + k) * ZW + ch) : zero4; }
#pragma unroll
    for (int it = 0; it < 3; ++it) { const int j = tq + 16 * it; R.rb[it] = (s0 - 16 + j >= 0) ? *(const u32x4*)(zm + (row0 + j - 16) * ZW + 512 + ch) : zero4; }
#pragma unroll
    for (int it = 0; it < 4; ++it) { const int j = tq + 16 * it; R.rc[it] = (j < 62 && s0 - 30 + j >= 0) ? *(const u32x4*)(zm + (row0 + j - 30) * ZW + 768 + ch) : zero4; }
}
__device__ __forceinline__ void mixers_run(int it0, int it1, const bf16_t* zm, bf16_t* ymix, const float* scw,
                                           const float* dww, const float* dwb, const float* clg, const float* clb, unsigned char* smem, int wv) {
    const int lane = fresh_lane(), tid = wv * 64 + lane;
    const int ch = (tid & 31) * 8, tq = tid >> 5;
    const int c = tid & 255, th = tid >> 8;
    float* P = (float*)smem;
    float* H = (float*)(smem + 49152);
    float* O = (float*)(smem + 112640);
    f32x4 wa0[3], wa1[3]; float w[31];
#pragma unroll
    for (int k = 0; k < 3; ++k) { wa0[k] = *(const f32x4*)(scw + k * 256 + ch); wa1[k] = *(const f32x4*)(scw + k * 256 + ch + 4); }
#pragma unroll
    for (int k = 0; k < 31; ++k) w[k] = dww[k * 256 + c];
    const float bias = dwb[c];
    const int hl = lane & 31, hf = lane >> 5;
    const f32x4 gq0 = *(const f32x4*)(clg + 8 * hl), gq1 = *(const f32x4*)(clg + 8 * hl + 4), bq0 = *(const f32x4*)(clb + 8 * hl), bq1 = *(const f32x4*)(clb + 8 * hl + 4);
    MixRaw R;
    if (it0 < it1) mix_load(R, it0, zm, tq, ch);
    for (int item = it0; item < it1; ++item) {
        const int b = item >> 8, s0 = (item & 255) * 32; const size_t row0 = (size_t)b * SEQ + s0;
#pragma unroll
        for (int it = 0; it < 3; ++it) { const int j = tq + 16 * it; float v[8]; unpack8(R.rb[it], v);
            *(f32x4*)(P + j * 256 + ch) = (f32x4){v[0], v[1], v[2], v[3]}; *(f32x4*)(P + j * 256 + ch + 4) = (f32x4){v[4], v[5], v[6], v[7]}; }
#pragma unroll
        for (int it = 0; it < 4; ++it) { const int j = tq + 16 * it; if (j < 62) { float v[8]; unpack8(R.rc[it], v);
            *(f32x4*)(H + j * 256 + ch) = (f32x4){v[0], v[1], v[2], v[3]}; *(f32x4*)(H + j * 256 + ch + 4) = (f32x4){v[4], v[5], v[6], v[7]}; } }
        __syncthreads();
#pragma unroll
        for (int it = 0; it < 2; ++it) {
            float zb[8], a[8]; unpack8(R.ra[it][0], zb);
#pragma unroll
            for (int j = 0; j < 8; ++j) a[j] = 0.f;
#pragma unroll
            for (int k = 0; k < 3; ++k) { float pz[8]; unpack8(R.ra[it][1 + k], pz);
                a[0] += wa0[k][0] * pz[0]; a[1] += wa0[k][1] * pz[1]; a[2] += wa0[k][2] * pz[2]; a[3] += wa0[k][3] * pz[3];
                a[4] += wa1[k][0] * pz[4]; a[5] += wa1[k][1] * pz[5]; a[6] += wa1[k][2] * pz[6]; a[7] += wa1[k][3] * pz[7]; }
#pragma unroll
            for (int j = 0; j < 8; ++j) a[j] *= zb[j];
            st8(ymix + (row0 + tq + 16 * it) * DM + ch, a);
        }
        if (item + 1 < it1) mix_load(R, item + 1, zm, tq, ch);
        {
            const int gI = wv >> 1, ww = 2 << gI, chb = gI * 64 + (lane & 7) * 8, tl = (lane >> 3) + 8 * (wv & 1);
#pragma unroll
            for (int it = 0; it < 2; ++it) {
                const int t = tl + 16 * it, s = s0 + t; const int cntv = (s + 1 < ww) ? (s + 1) : ww;
                f32x4 a0 = (f32x4){0.f, 0.f, 0.f, 0.f}, a1 = a0;
                for (int j = 0; j < ww; ++j) { a0 += *(const f32x4*)(P + (16 + t - j) * 256 + chb); a1 += *(const f32x4*)(P + (16 + t - j) * 256 + chb + 4); }
                const float inv = __builtin_amdgcn_rcpf((float)cntv);
                const f32x4 z0 = *(const f32x4*)(P + (16 + t) * 256 + chb), z1 = *(const f32x4*)(P + (16 + t) * 256 + chb + 4);
                a0 = a0 * inv - z0; a1 = a1 * inv - z1;
                float o[8] = {a0[0], a0[1], a0[2], a0[3], a1[0], a1[1], a1[2], a1[3]};
                st8(ymix + (row0 + t) * DM + 256 + chb, o);
            }
        }
        {
            float win[46];
#pragma unroll
            for (int q = 0; q < 46; ++q) win[q] = H[(th * 16 + q) * 256 + c];
#pragma unroll
            for (int j = 0; j < 16; ++j) { float o = bias;
#pragma unroll
                for (int k = 0; k < 31; ++k) o += w[k] * win[j + k];
                O[(th * 16 + j) * 256 + c] = o; }
        }
        __syncthreads();
#pragma unroll
        for (int q = 0; q < 2; ++q) {
            const int t = wv * 4 + 2 * q + hf;
            const f32x4 v0 = *(const f32x4*)(O + t * 256 + 8 * hl), v1 = *(const f32x4*)(O + t * 256 + 8 * hl + 4);
            float s = ((v0[0] + v0[1]) + (v0[2] + v0[3])) + ((v1[0] + v1[1]) + (v1[2] + v1[3]));
#pragma unroll
            for (int o = 1; o < 32; o <<= 1) s += shfl_xor_l(s, o, lane);
            const float mean = s * (1.0f / 256.0f);
            const f32x4 d0 = v0 - mean, d1 = v1 - mean;
            float qv = ((d0[0] * d0[0] + d0[1] * d0[1]) + (d0[2] * d0[2] + d0[3] * d0[3])) + ((d1[0] * d1[0] + d1[1] * d1[1]) + (d1[2] * d1[2] + d1[3] * d1[3]));
#pragma unroll
            for (int o = 1; o < 32; o <<= 1) qv += shfl_xor_l(qv, o, lane);
            const float rstd = __builtin_amdgcn_rsqf(qv * (1.0f / 256.0f) + LN_EPS);
            const f32x4 y0 = d0 * rstd * gq0 + bq0, y1 = d1 * rstd * gq1 + bq1;
            u32x4 o4; o4.x = cvt_pk_bf16(siluf_(y0[0]), siluf_(y0[1])); o4.y = cvt_pk_bf16(siluf_(y0[2]), siluf_(y0[3]));
            o4.z = cvt_pk_bf16(siluf_(y1[0]), siluf_(y1[1])); o4.w = cvt_pk_bf16(siluf_(y1[2]), siluf_(y1[3]));
            *(u32x4*)(ymix + (row0 + t) * DM + 512 + 8 * hl) = o4;
        }
        __syncthreads();
    }
}

__global__ void __launch_bounds__(NTHREADS, 2) trunk_fwd(Args args) {
    extern __shared__ __attribute__((aligned(16))) unsigned char smem[];
    cg::grid_group grid = cg::this_grid();
    LAS unsigned char* lds = (LAS unsigned char*)smem;
    const int tid = threadIdx.x, lane = tid & 63, wave = __builtin_amdgcn_readfirstlane(tid >> 6);
    const int bid = blockIdx.x, G = gridDim.x;
    const int gtid = bid * NTHREADS + tid, GT = G * NTHREADS;

    if (tid < 4) ((unsigned*)(smem + XB_LDS_OFF))[tid] = 0u;
    if (tid == 0) (void)xb_add((unsigned*)(args.ws + WS_CTL) + CW_XB + XB_XCNT(xb_xcc_id()), 1u);
    __syncthreads();
    PH_T0();
    {
        PH_PTRS0
        float* scr = (float*)(smem + wave * 16384);
        const int gw = bid * 8 + wave, NGW = G * 8;
        constexpr int I_IN = 16 * 56, I_O = 16 * 32, I_G = 16 * 88, I_D = 44 * 32, I_GLU = 4 * 8, I_L = I_IN + I_O + 2 * I_G + I_D + I_GLU;
        for (int it = gw; it < DEPTH * I_L; it += NGW) {
            const int l = it / I_L; int r = it % I_L;
            if (r < I_IN) { transpose_item(ka->in[4] + (size_t)l * DM * INW, DM, INW, win_t + (size_t)l * INW * DM, 3, scr, r, lane); continue; } r -= I_IN;
            if (r < I_O) {
                const int kb = r / 32;
                if (kb >= 4 && kb < 8) fused_pool_item(ka->in[23] + (size_t)l * DM * DM, ka->in[7] + (size_t)l * 16384 + (kb - 4) * 4096, ka->in[8] + l * 256 + (kb - 4) * 64, wo_t + (size_t)l * DM * DM, scr, r, lane);
                else transpose_item(ka->in[23] + (size_t)l * DM * DM, DM, DM, wo_t + (size_t)l * DM * DM, 0, scr, r, lane);
                continue; } r -= I_O;
            if (r < I_G) { transpose_item(ka->in[26] + (size_t)l * DM * FF, DM, FF, wgu_t + (size_t)l * 2 * FF * DM, 1, scr, r, lane); continue; } r -= I_G;
            if (r < I_G) { transpose_item(ka->in[27] + (size_t)l * DM * FF, DM, FF, wgu_t + (size_t)l * 2 * FF * DM, 2, scr, r, lane); continue; } r -= I_G;
            if (r < I_D) { transpose_item(ka->in[28] + (size_t)l * FF * DM, FF, DM, wdn_t + (size_t)l * DM * FF, 0, scr, r, lane); continue; } r -= I_D;
            transpose_item(ka->in[21] + (size_t)l * 65536, 256, 256, wglu_t + (size_t)l * 65536, 0, scr, r, lane);
        }
        __syncthreads();
        float* cond = (float*)smem; float* red = (float*)(smem + 32768);
        for (int i = tid; i < NB * DM; i += NTHREADS) { const float v = ka->in[1][i]; cond[i] = siluf_(v); }
        __syncthreads();
        for (int item = bid; item < DEPTH * 96; item += G) {
            const int l = item / 96, n = (item % 96) * 64 + lane;
            const float* Wp = ka->in[2] + (size_t)l * DM * 6144 + n;
            float a[8];
#pragma unroll
            for (int q = 0; q < 8; ++q) a[q] = 0.f;
            for (int k0 = wave * 128; k0 < wave * 128 + 128; k0 += 16) {
                float wv_[16];
#pragma unroll
                for (int j = 0; j < 16; ++j) wv_[j] = Wp[(size_t)(k0 + j) * 6144];
#pragma unroll
                for (int j = 0; j < 16; ++j)
#pragma unroll
                    for (int q = 0; q < 8; ++q) a[q] += cond[q * DM + k0 + j] * wv_[j];
            }
#pragma unroll
            for (int q = 0; q < 8; ++q) red[(wave * 8 + q) * 64 + lane] = a[q];
            __syncthreads();
            float s = 0.f;
#pragma unroll
            for (int w2 = 0; w2 < 8; ++w2) s += red[(w2 * 8 + wave) * 64 + lane];
            mod[(size_t)(l * 8 + wave) * 6144 + n] = s + ka->in[3][l * 6144 + n];
            __syncthreads();
        }
        if (gtid < DEPTH * 16 * 64) {
            const int idx = gtid, lg = idx >> 6;
            const float dt = __expf(ka->in[15][lg]), lr = ka->in[13][idx], li = ka->in[14][idx];
            const float a = lr * dt, tt = li * dt * 0.15915494309189535f;
            float lbr = 0.f, lbi = 0.f;
            for (int k = 0; k <= 32; ++k) {
                const float mag = __expf((float)k * a), tk = (float)k * tt, frc = tk - rintf(tk);
                const float cr = mag * __builtin_amdgcn_cosf(frc), ci = mag * __builtin_amdgcn_sinf(frc);
                pw[idx * 33 + k] = (f32x2){cr, ci};
                if (k == 1) { lbr = cr; lbi = ci; }
            }
            const float nr = lbr - 1.0f, ni = lbi, inv = 1.0f / (lr * lr + li * li);
            const float qr = (nr * lr + ni * li) * inv, qi = (ni * lr - nr * li) * inv;
            for (int h = 0; h < 16; ++h) { const float br = ka->in[16][idx * 16 + h], bi = ka->in[17][idx * 16 + h];
                bbar[idx * 16 + h] = (f32x2){qr * br - qi * bi, qr * bi + qi * br}; }
        }
    }
    grid.sync();
    {
        PH_PTRS0
        for (int idx = gtid; idx < DEPTH * 16 * 32 * 256; idx += GT) {
            const int hp = idx & 15, h = (idx >> 4) & 15, k = (idx >> 8) & 31, lg = idx >> 13;
            const float* cre = ka->in[18] + (size_t)(lg * 16 + h) * 64; const float* cim = ka->in[19] + (size_t)(lg * 16 + h) * 64;
            float sum = 0.f;
            for (int p = 0; p < 64; ++p) { const f32x2 w = pw[(lg * 64 + p) * 33 + k], bb = bbar[(lg * 64 + p) * 16 + hp];
                const float tr = w.x * bb.x - w.y * bb.y, ti = w.x * bb.y + w.y * bb.x; sum += cre[p] * tr - cim[p] * ti; }
            Kk[idx] = sum;
        }
        for (int idx = gtid; idx < DEPTH * 16 * 256 * 32; idx += GT) {
            const int s = idx & 31, row = (idx >> 5) & 255, lg = idx >> 13;
            bf16_t* dst = w1m + ((size_t)(lg * 256 + row) * 512 + s * 16);
            float v[16];
            if (row < 128) { const int p = row >> 1, ri = row & 1; const f32x2 w = pw[(lg * 64 + p) * 33 + (31 - s)];
#pragma unroll
                for (int hp = 0; hp < 16; ++hp) { const f32x2 bb = bbar[(lg * 64 + p) * 16 + hp]; v[hp] = ri ? (w.x * bb.y + w.y * bb.x) : (w.x * bb.x - w.y * bb.y); } }
            else {
#pragma unroll
                for (int hp = 0; hp < 16; ++hp) v[hp] = 0.f;
            }
            u32x4 o0, o1; o0.x = cvt_pk_bf16(v[0], v[1]); o0.y = cvt_pk_bf16(v[2], v[3]); o0.z = cvt_pk_bf16(v[4], v[5]); o0.w = cvt_pk_bf16(v[6], v[7]);
            o1.x = cvt_pk_bf16(v[8], v[9]); o1.y = cvt_pk_bf16(v[10], v[11]); o1.z = cvt_pk_bf16(v[12], v[13]); o1.w = cvt_pk_bf16(v[14], v[15]);
            *(u32x4*)dst = o0; *(u32x4*)(dst + 8) = o1;
        }
        for (int idx = gtid; idx < DEPTH * 16 * 32 * 16 * 8; idx += GT) {
            const int pc = idx & 7, h = (idx >> 3) & 15, t = (idx >> 7) & 31, lg = idx >> 12;
            bf16_t* dst = btout + ((size_t)(lg * 512 + t * 16 + h) * KSSM + 512 + pc * 16);
            const float* cre = ka->in[18] + (size_t)(lg * 16 + h) * 64 + pc * 8; const float* cim = ka->in[19] + (size_t)(lg * 16 + h) * 64 + pc * 8;
            float v[16];
#pragma unroll
            for (int j = 0; j < 8; ++j) { const f32x2 w = pw[(lg * 64 + pc * 8 + j) * 33 + t + 1]; const float cr = cre[j], ci = cim[j];
                v[2 * j] = cr * w.x - ci * w.y; v[2 * j + 1] = -(cr * w.y + ci * w.x); }
            u32x4 o0, o1; o0.x = cvt_pk_bf16(v[0], v[1]); o0.y = cvt_pk_bf16(v[2], v[3]); o0.z = cvt_pk_bf16(v[4], v[5]); o0.w = cvt_pk_bf16(v[6], v[7]);
            o1.x = cvt_pk_bf16(v[8], v[9]); o1.y = cvt_pk_bf16(v[10], v[11]); o1.z = cvt_pk_bf16(v[12], v[13]); o1.w = cvt_pk_bf16(v[14], v[15]);
            *(u32x4*)dst = o0; *(u32x4*)(dst + 8) = o1;
        }
        for (int idx = gtid; idx < 8 * NB * DM; idx += GT) {
            const int c = idx & (DM - 1), bb = (idx >> 10) & 7, j = idx >> 13, lj = j >> 1, wh = j & 1;
            const float* ml = mod + (size_t)(lj * 8 + bb) * 6144;
            const float gg = ml[(wh ? 5120 : 2048) + c], ps = ml[(wh ? 4096 : 1024) + c], ph = ml[(wh ? 3072 : 0) + c];
            const float lg = (wh ? ka->in[29] : ka->in[24])[lj * DM + c], lb = (wh ? ka->in[30] : ka->in[25])[lj * DM + c];
            float hs = 0.f, hh = 0.f;
            if (!wh) { hs = ml[4096 + c]; hh = ml[3072 + c]; }
            else if (lj + 1 < DEPTH) { const float* mn = mod + (size_t)((lj + 1) * 8 + bb) * 6144; hs = mn[1024 + c]; hh = mn[c]; }
            const float pa = ALPHA / (1.0f + ps);
            float* t = (float*)(ws + WS_LNT) + (size_t)(j * 8 + bb) * 5120 + c;
            t[0] = 1.0f + gg; t[1024] = pa; t[2048] = ph * pa; t[3072] = lg * (1.0f + hs); t[4096] = lb * (1.0f + hs) + hh;
        }
        for (size_t idx0 = gtid; idx0 < (size_t)MTOK * DM / 8; idx0 += (size_t)4 * GT) {
            f32x4 xa[4], xb[4];
#pragma unroll
            for (int uu = 0; uu < 4; ++uu) { const size_t e = (idx0 + (size_t)uu * GT) * 8; xa[uu] = *(const f32x4*)(ka->in[0] + e); xb[uu] = *(const f32x4*)(ka->in[0] + e + 4); }
#pragma unroll
            for (int uu = 0; uu < 4; ++uu) {
                const size_t e = (idx0 + (size_t)uu * GT) * 8; const int col = (int)(e & (DM - 1)); const int b = (int)(e >> 23);
                const float* mb = mod + (size_t)b * 6144;
                const f32x4 sh0 = *(const f32x4*)(mb + col), sh1 = *(const f32x4*)(mb + col + 4), sc0 = *(const f32x4*)(mb + 1024 + col), sc1 = *(const f32x4*)(mb + 1024 + col + 4);
                const f32x4 h0 = xa[uu] * (sc0 + 1.0f) + sh0, h1 = xb[uu] * (sc1 + 1.0f) + sh1;
                u32x4 w; w.x = cvt_pk_bf16(h0[0], h0[1]); w.y = cvt_pk_bf16(h0[2], h0[3]); w.z = cvt_pk_bf16(h1[0], h1[1]); w.w = cvt_pk_bf16(h1[2], h1[3]);
                *(u32x4*)(hmod + e) = w;
            }
        }
    }
    grid_bar(wave, smem);
    { PH_PTRS0
    for (int idx = gtid; idx < DEPTH * 16 * 32 * 16 * 32; idx += GT) {
        const int s = idx & 31, h = (idx >> 5) & 15, t = (idx >> 9) & 31, lg = idx >> 14;
        bf16_t* dst = btout + ((size_t)(lg * 512 + t * 16 + h) * KSSM + s * 16);
        float v[16];
        if (s <= t) { const float* kp = Kk + ((size_t)(lg * 32 + (t - s)) * 16 + h) * 16; const float dd = (s == t) ? ka->in[20][lg * 16 + h] : 0.f;
#pragma unroll
            for (int hp = 0; hp < 16; ++hp) v[hp] = kp[hp] + (hp == h ? dd : 0.f); }
        else {
#pragma unroll
            for (int hp = 0; hp < 16; ++hp) v[hp] = 0.f;
        }
        u32x4 o0, o1; o0.x = cvt_pk_bf16(v[0], v[1]); o0.y = cvt_pk_bf16(v[2], v[3]); o0.z = cvt_pk_bf16(v[4], v[5]); o0.w = cvt_pk_bf16(v[6], v[7]);
        o1.x = cvt_pk_bf16(v[8], v[9]); o1.y = cvt_pk_bf16(v[10], v[11]); o1.z = cvt_pk_bf16(v[12], v[13]); o1.w = cvt_pk_bf16(v[14], v[15]);
        *(u32x4*)dst = o0; *(u32x4*)(dst + 8) = o1;
    }
    }
    PH_AMP(0);

    for (int l = 0; l < DEPTH; ++l) {
        for (int rep = 0; rep < REP_MIX; ++rep) {
        { PH_T0();
        {
            PH_PTRS
            pg8::Gemm g{hmod, win_t + (size_t)l * INW * DM, DM, DM, DM};
            pg8::StaticOrder S; S.init(MTOK, INW, G, bid);
            pg8::EpiZ E{zmain, apr, ka->in[5] + l * INW};
            pg8::gemm_phase<pg8::EpiZ, pg8::StaticOrder, true>(lds, g, S, E, wave);
        }
        PH_AMP(1); }
        grid_bar(wave, smem);
        { PH_T0();
        {
            PH_PTRS
            int bidl = bid; asm volatile("" : "+s"(bidl));
            if (bidl < 128) {
                const int gq = bidl >> 3;
                {
                    pg8::Gemm g{apr, w1m + (size_t)l * 4096 * 512, 512, KSSM, 512};
                    pg8::OneUnit S{bidl, gq, true};
                    pg8::EpiStates E{Sst};
                    pg8::gemm_phase<pg8::EpiStates, pg8::OneUnit, true>(lds, g, S, E, wave);
                }
                asm volatile("s_waitcnt vmcnt(0)" ::: "memory");
                __syncthreads();
                {
                    int wvl = wave; asm volatile("" : "+s"(wvl));
                    const int ln = fresh_lane(); const int rowbase = bidl * NCH + wvl * 32;
                    const f32x2 mult = pw[((l * 16 + gq) * 64 + ln) * 33 + 32];
                    f32x2 sv[32];
#pragma unroll
                    for (int j = 0; j < 32; ++j) sv[j] = *(const f32x2*)(Sst + (size_t)(rowbase + j) * 128 + 2 * ln);
                    float er = 0.f, ei = 0.f;
#pragma unroll
                    for (int j = 0; j < 32; ++j) { const float nr = mult.x * er - mult.y * ei + sv[j].x, ni = mult.x * ei + mult.y * er + sv[j].y; er = nr; ei = ni; }
                    f32x2* ex = (f32x2*)(smem + 131072);
                    ex[wvl * 64 + ln] = (f32x2){er, ei};
                    float mr = mult.x, mi = mult.y;
#pragma unroll
                    for (int q = 0; q < 5; ++q) { const float nr = mr * mr - mi * mi, ni = 2.0f * mr * mi; mr = nr; mi = ni; }
                    __syncthreads();
                    float xr = 0.f, xi = 0.f;
                    for (int w2 = 0; w2 < wvl; ++w2) { const f32x2 e = ex[w2 * 64 + ln]; const float nr = mr * xr - mi * xi + e.x, ni = mr * xi + mi * xr + e.y; xr = nr; xi = ni; }
#pragma unroll
                    for (int j = 0; j < 32; ++j) {
                        *(unsigned*)(apr + (size_t)(rowbase + j) * KSSM + 512 + 2 * ln) = cvt_pk_bf16(xr, xi);
                        const float nr = mult.x * xr - mult.y * xi + sv[j].x, ni = mult.x * xi + mult.y * xr + sv[j].y; xr = nr; xi = ni;
                    }
                }
                asm volatile("s_waitcnt vmcnt(0)" ::: "memory");
                __syncthreads();
                {
                    pg8::Gemm g{apr, btout + (size_t)l * 8192 * KSSM, KSSM, KSSM, KSSM};
                    pg8::PairOrder S{bidl, gq * 2};
                    pg8::EpiSsmOut E{yg};
                    pg8::gemm_phase<pg8::EpiSsmOut, pg8::PairOrder, true>(lds, g, S, E, wave);
                }
                __syncthreads();
            }
            const int it0 = bidl < 128 ? bidl * 5 : 640 + (bidl - 128) * 11, it1 = it0 + (bidl < 128 ? 5 : 11);
            mixers_run(it0, it1, zmain, ymix, ka->in[6] + l * 768, ka->in[9] + l * 7936,
                       ka->in[10] + l * 256, ka->in[11] + l * 256, ka->in[12] + l * 256, smem, wave);
        }
        PH_AMP(2); }
        grid_bar(wave, smem);
        { PH_T0();
        {
            PH_PTRS
            pg8::Gemm g{yg, wglu_t + (size_t)l * 65536, 256, 256, 256};
            pg8::StaticOrder S; S.init(MTOK, 256, G, bid);
            pg8::EpiGlu E{yg, ymix, ka->in[22] + l * 256};
            pg8::gemm_phase<pg8::EpiGlu, pg8::StaticOrder, true>(lds, g, S, E, wave);
        }
        PH_AMP(4); }
        grid_bar(wave, smem);
        }
        { PH_T0();
        {
            PH_PTRS
            pg8::Gemm g{ymix, wo_t + (size_t)l * DM * DM, DM, DM, DM};
            pg8::RoundOrder S{bid & 7, bid >> 3};
            pg8::EpiLn E{(float*)nullptr, hmod, (const float*)(ws + WS_LNT) + (size_t)(2 * l) * 8 * 5120,
                         (unsigned long long*)(ws + WS_XCH), ctl + CW_TMO, (unsigned)(2 * l) & 7u, lds + 131072};
            pg8::gemm_phase<pg8::EpiLn, pg8::RoundOrder, true>(lds, g, S, E, wave);
        }
        PH_AMP(5); }
        grid_bar(wave, smem);
        { PH_T0();
        for (int rep = 0; rep < REP_P6; ++rep) {
            PH_PTRS
            pg8::Gemm g{hmod, wgu_t + (size_t)l * 2 * FF * DM, DM, DM, DM};
            pg8::StaticOrder S; S.init(MTOK, 2 * FF, G, bid);
            pg8::EpiSwiGlu E{hid};
            pg8::gemm_phase<pg8::EpiSwiGlu, pg8::StaticOrder, true>(lds, g, S, E, wave);
        }
        PH_AMP(6); }
        grid_bar(wave, smem);
        { PH_T0();
        {
            PH_PTRS
            const float* modn = mod + (size_t)(l + 1 < DEPTH ? l + 1 : l) * 8 * 6144;
            pg8::Gemm g{hid, wdn_t + (size_t)l * DM * FF, FF, FF, FF};
            pg8::RoundOrder S{bid & 7, bid >> 3};
            pg8::EpiLn E{(l + 1 < DEPTH) ? (float*)nullptr : xres, hmod, (const float*)(ws + WS_LNT) + (size_t)(2 * l + 1) * 8 * 5120,
                         (unsigned long long*)(ws + WS_XCH), ctl + CW_TMO, (unsigned)(2 * l + 1) & 7u, lds + 131072};
            pg8::gemm_phase<pg8::EpiLn, pg8::RoundOrder, true>(lds, g, S, E, wave);
        }
        PH_AMP(7); }
        grid_bar(wave, smem);
    }
}

extern "C" void kernel_launch(void* const* d_in, const int* in_sizes, int n_in, void* d_out, int out_size, void* d_ws, size_t ws_size, hipStream_t stream) {
    static int ready = 0;
    if (ready == 0) {
        ready = 1;
        if (n_in != 31 || out_size != MTOK * DM || ws_size < WS_END) { fprintf(stderr, "kernel_launch: unexpected shapes (n_in %d, out %d, ws %zu)\n", n_in, out_size, ws_size); ready = -1; }
        else if (hipFuncSetAttribute((const void*)trunk_fwd, hipFuncAttributeMaxDynamicSharedMemorySize, LDS_BYTES) != hipSuccess) { fprintf(stderr, "kernel_launch: hipFuncSetAttribute failed\n"); ready = -1; }
        else { int per_cu = 0; if (hipOccupancyMaxActiveBlocksPerMultiprocessor(&per_cu, (const void*)trunk_fwd, NTHREADS, LDS_BYTES) != hipSuccess || per_cu < 1) fprintf(stderr, "kernel_launch: occupancy query reports %d\n", per_cu); (void)hipGetLastError(); }
    }
    if (ready < 0) return;
    (void)hipMemsetAsync((char*)d_ws + WS_CTL, 0, CTL_BYTES, stream);
    Args a{};
    for (int i = 0; i < 31; ++i) a.in[i] = (const float*)d_in[i];
    a.out = (float*)d_out; a.ws = (unsigned char*)d_ws;
    void* kargs[] = {&a};
    hipError_t e = hipLaunchCooperativeKernel((const void*)trunk_fwd, dim3(GRID), dim3(NTHREADS), kargs, LDS_BYTES, stream);
    if (e != hipSuccess) fprintf(stderr, "kernel_launch: cooperative launch failed: %s\n", hipGetErrorString(e));
}
```
